# Optimizing an MI355X kernel written in HIP

```python
import math
import jax, jax.numpy as jnp
from jax import lax
import numpy as np

D_MODEL = 2048
BATCH = 8
SEQ = 2048
DEPTH = 2

GRID_W = 64
CTX_LEN = 256
NORM_EPS = 1e-6

RW_HEADS = 8
RW_HD = 64
RW_W = RW_HEADS * RW_HD
RW_DECAY_RANK = 64
RW_ICLR_RANK = 64
RW_GATE_RANK = 128
RW_GN_EPS = 64e-5
RW_IN = 3 * RW_W + 2 * RW_DECAY_RANK + 2 * RW_ICLR_RANK + RW_GATE_RANK

SSD_HEADS = 8
SSD_HD = 64
SSD_W = SSD_HEADS * SSD_HD
SSD_GROUPS = 2
SSD_STATE = 128
SSD_CONV = 3
SSD_CHUNK = 128
SSD_XBC = SSD_W + 2 * SSD_GROUPS * SSD_STATE
SSD_IN = SSD_W + SSD_XBC + 2 * SSD_HEADS

DA_HEADS = 4
DA_HD = 64
DA_W = DA_HEADS * 2 * DA_HD
DA_IN = 3 * DA_W
DA_BLOCK = 128
DA_SUBLN_EPS = 1e-5

NA_HEADS = 8
NA_HD = 64
NA_W = NA_HEADS * NA_HD
NA_IN = 3 * NA_W
NA_WIN_R = 8
NA_WIN_C = 16

N_BRANCH = 4
BR_W = 512
IN_SIZES = (RW_IN, SSD_IN, DA_IN, NA_IN)
IN_TOTAL = RW_IN + SSD_IN + DA_IN + NA_IN

D_FF = 5632
FFN_CONV = 3
ROPE_BASE = 10000.0

kernel_name = 'hybrid_prefix_dit_block'


def _split(x, sizes):
    return jnp.split(x, np.cumsum(sizes)[:-1].tolist(), axis=-1)


def rmsnorm(x, g, eps=NORM_EPS):
    xf = x.astype(jnp.float32)
    y = xf * lax.rsqrt(jnp.mean(xf * xf, axis=-1, keepdims=True) + eps)
    return (y * g.astype(jnp.float32)).astype(x.dtype)


def dwconv_centred(x, w, b):
    k_w = w.shape[0]
    length = x.shape[1]
    pad = k_w // 2
    xp = jnp.pad(x, ((0, 0), (pad, pad), (0, 0)))
    y = b + xp[:, 0:length] * w[0]
    for j in range(1, k_w):
        y = y + xp[:, j:j + length] * w[j]
    return y


def token_shift_bi(p, mu_prev, mu_next):
    zero = jnp.zeros_like(p[:, :1])
    prev = jnp.concatenate([zero, p[:, :-1]], axis=1)
    nxt = jnp.concatenate([p[:, 1:], zero], axis=1)
    return p + mu_prev * (prev - p) + mu_next * (nxt - p)


def rope2d(x):
    length, dh = x.shape[1], x.shape[-1]
    n_freq = dh // 4
    t = jnp.arange(length)
    pos = jnp.stack([t // GRID_W, t % GRID_W], axis=-1).astype(jnp.float32)
    inv = ROPE_BASE ** (-jnp.arange(n_freq, dtype=jnp.float32) / n_freq)
    ang = pos[:, :, None] * inv
    cos = jnp.cos(ang)[:, None, None]
    sin = jnp.sin(ang)[:, None, None]
    xr = x.astype(jnp.float32).reshape(*x.shape[:-1], 2, 2, n_freq)
    x1, x2 = xr[..., 0, :], xr[..., 1, :]
    out = jnp.stack([x1 * cos - x2 * sin, x2 * cos + x1 * sin], axis=-2)
    return out.reshape(x.shape).astype(x.dtype)


def rwkv_prep(p, mu, w0, w_up, a0, a_up, g_up, k_k, k_a):
    bsz, length, _ = p.shape
    p = token_shift_bi(p, mu[0], mu[1]).astype(jnp.float32)
    r, k, v, wd, ad, gd = _split(p, (RW_W, RW_W, RW_W, 2 * RW_DECAY_RANK, 2 * RW_ICLR_RANK, RW_GATE_RANK))
    wd = wd.reshape(bsz, length, 2, RW_DECAY_RANK)
    ad = ad.reshape(bsz, length, 2, RW_ICLR_RANK)
    w_raw = w0 + jnp.einsum('bldr,drc->bldc', jnp.tanh(wd), w_up)
    decay = jnp.exp(-jnp.exp(-jax.nn.softplus(-w_raw) - 0.5))
    a = jax.nn.sigmoid(a0 + jnp.einsum('bldr,drc->bldc', ad, a_up))
    g = jax.nn.sigmoid(gd) @ g_up
    heads = lambda t: t.reshape(*t.shape[:-1], RW_HEADS, RW_HD)
    kk = heads(k * k_k)
    kk = kk / jnp.maximum(jnp.linalg.norm(kk, axis=-1, keepdims=True), 1e-12)
    k_dir = heads(k[:, :, None] * (1.0 + (a - 1.0) * k_a))
    return (heads(r), heads(decay), k_dir, heads(v), kk, heads(a), g)


def wkv_scan(r, w, k, v, kk, b, s0, reverse):
    def step(s, inp):
        r_t, w_t, k_t, v_t, kk_t, b_t = inp
        sa = jnp.einsum('bhvk,bhk->bhv', s, kk_t)
        s = s * w_t[:, :, None, :] - sa[..., None] * b_t[:, :, None, :] + v_t[..., None] * k_t[:, :, None, :]
        return s, jnp.einsum('bhvk,bhk->bhv', s, r_t)
    xs = tuple(jnp.swapaxes(t, 0, 1) for t in (r, w, k, v, kk, b))
    s, o = lax.scan(step, s0, xs, reverse=reverse)
    return jnp.swapaxes(o, 0, 1), s


def rwkv_bidir(prep, inits):
    r, decay, k_dir, v, kk, a, _ = prep
    b = kk[:, :, None] * a
    o_f, s_f = wkv_scan(r, decay[:, :, 0], k_dir[:, :, 0], v, kk, b[:, :, 0], inits[0], False)
    o_b, s_b = wkv_scan(r, decay[:, :, 1], k_dir[:, :, 1], v, kk, b[:, :, 1], inits[1], True)
    return o_f + o_b, (s_f, s_b)


def rwkv_readout(o, prep, r_k, ln_g, ln_b):
    r, _, k_dir, v, _, _, g = prep
    bsz, length = o.shape[:2]
    mu = jnp.mean(o, axis=-1, keepdims=True)
    var = jnp.mean(jnp.square(o - mu), axis=-1, keepdims=True)
    on = ((o - mu) * lax.rsqrt(var + RW_GN_EPS)).reshape(bsz, length, RW_W) * ln_g + ln_b
    bonus = jnp.sum(jnp.sum(r[:, :, None] * k_dir * r_k, axis=-1, keepdims=True) * v[:, :, None], axis=2)
    return (on + bonus.reshape(bsz, length, RW_W)) * g


def rwkv7_mixer(pl, pc, lp, ctx_out):
    prep_args = (lp['rw_mu'], lp['rw_w0'], lp['rw_w_up'], lp['rw_a0'], lp['rw_a_up'],
                 lp['rw_g_up'], lp['rw_k_k'], lp['rw_k_a'])
    prep_c = rwkv_prep(pc, *prep_args)
    prep_l = rwkv_prep(pl, *prep_args)
    s0 = jnp.zeros((pl.shape[0], RW_HEADS, RW_HD, RW_HD), jnp.float32)
    o_c, fin_c = rwkv_bidir(prep_c, (s0, s0))
    o_l, _ = rwkv_bidir(prep_l, fin_c)
    ro = (lp['rw_r_k'], lp['rw_ln_g'], lp['rw_ln_b'])
    out_l = rwkv_readout(o_l, prep_l, *ro)
    out_c = rwkv_readout(o_c, prep_c, *ro) if ctx_out else None
    return out_l, out_c


def ssd_prep(p, conv_w, conv_b, dt_bias):
    bsz, length, _ = p.shape
    z, xbc, dt_raw = _split(p, (SSD_W, SSD_XBC, 2 * SSD_HEADS))
    xbc = jax.nn.silu(dwconv_centred(xbc, conv_w, conv_b)).astype(jnp.float32)
    xs, bm, cm = _split(xbc, (SSD_W, SSD_GROUPS * SSD_STATE, SSD_GROUPS * SSD_STATE))
    xs = xs.reshape(bsz, length, SSD_HEADS, SSD_HD)
    bm = bm.reshape(bsz, length, SSD_GROUPS, SSD_STATE)
    cm = cm.reshape(bsz, length, SSD_GROUPS, SSD_STATE)
    dt = jax.nn.softplus(dt_raw.astype(jnp.float32).reshape(bsz, length, 2, SSD_HEADS) + dt_bias)
    return (z.astype(jnp.float32), xs, bm, cm, dt)


def ssd_chunked(x, dt, a, bm, cm, h0):
    bsz, length, n_h, n_p = x.shape
    q = SSD_CHUNK
    nc = length // q
    rep = n_h // SSD_GROUPS
    xq = x.reshape(bsz, nc, q, n_h, n_p)
    dtq = dt.reshape(bsz, nc, q, n_h)
    bh = jnp.repeat(bm, rep, axis=2).reshape(bsz, nc, q, n_h, SSD_STATE)
    ch = jnp.repeat(cm, rep, axis=2).reshape(bsz, nc, q, n_h, SSD_STATE)
    acs = jnp.cumsum(jnp.swapaxes(dtq * a, 2, 3), axis=-1)
    seg = acs[..., :, None] - acs[..., None, :]
    tri = jnp.tril(jnp.ones((q, q), dtype=bool))
    decay_ij = jnp.exp(jnp.where(tri, seg, -jnp.inf))
    scores = jnp.einsum('bcihn,bcjhn->bchij', ch, bh) * decay_ij
    y_diag = jnp.einsum('bchij,bcjh,bcjhp->bcihp', scores, dtq, xq)
    to_end = jnp.exp(acs[..., -1:] - acs)
    states = jnp.einsum('bchj,bcjh,bcjhn,bcjhp->bchpn', to_end, dtq, bh, xq)
    chunk_decay = jnp.exp(acs[..., -1])

    def step(h, inp):
        st, dec = inp
        return h * dec[..., None, None] + st, h
    h_last, h_in = lax.scan(step, h0, (jnp.swapaxes(states, 0, 1), jnp.swapaxes(chunk_decay, 0, 1)))
    h_in = jnp.swapaxes(h_in, 0, 1)
    y_off = jnp.einsum('bcihn,bchpn,bchi->bcihp', ch, h_in, jnp.exp(acs))
    return (y_diag + y_off).reshape(bsz, length, n_h, n_p), h_last


def ssd_bidir(prep, a_log, inits):
    _, xs, bm, cm, dt = prep
    a = -jnp.exp(a_log.astype(jnp.float32))
    flip = lambda t: jnp.flip(t, axis=1)
    y_f, h_f = ssd_chunked(xs, dt[:, :, 0], a[0], bm, cm, inits[0])
    y_b, h_b = ssd_chunked(flip(xs), flip(dt[:, :, 1]), a[1], flip(bm), flip(cm), inits[1])
    return y_f + flip(y_b), (h_f, h_b)


def ssd_readout(y, prep, d_skip, norm_g):
    z, xs = prep[0], prep[1]
    bsz, length = y.shape[:2]
    y = (y + d_skip[:, None] * xs).reshape(bsz, length, SSD_W)
    return rmsnorm(y * jax.nn.silu(z), norm_g)


def ssd_mixer(pl, pc, lp, ctx_out):
    prep_c = ssd_prep(pc, lp['ssd_conv_w'], lp['ssd_conv_b'], lp['ssd_dt_bias'])
    prep_l = ssd_prep(pl, lp['ssd_conv_w'], lp['ssd_conv_b'], lp['ssd_dt_bias'])
    h0 = jnp.zeros((pl.shape[0], SSD_HEADS, SSD_HD, SSD_STATE), jnp.float32)
    y_c, fin_c = ssd_bidir(prep_c, lp['ssd_a_log'], (h0, h0))
    y_l, _ = ssd_bidir(prep_l, lp['ssd_a_log'], fin_c)
    out_l = ssd_readout(y_l, prep_l, lp['ssd_d'], lp['ssd_norm_g'])
    out_c = ssd_readout(y_c, prep_c, lp['ssd_d'], lp['ssd_norm_g']) if ctx_out else None
    return out_l, out_c


def diff_attention(pl, pc, lp, layer_idx, ctx_out):
    bsz, seq, _ = pl.shape

    def qkv(p):
        q, k, v = _split(p, (DA_W, DA_W, DA_W))
        sh = (p.shape[0], p.shape[1], DA_HEADS, 2, DA_HD)
        return q.reshape(sh), k.reshape(sh), v.reshape(p.shape[0], p.shape[1], DA_HEADS, 2 * DA_HD)
    ql, kl, vl = qkv(pl)
    qc, kc, vc = qkv(pc)
    ql, kl = rope2d(ql), rope2d(kl)
    lam_init = 0.8 - 0.6 * math.exp(-0.3 * layer_idx)
    lam_p = lp['da_lambda'].astype(jnp.float32)
    lam = jnp.exp(jnp.sum(lam_p[0] * lam_p[1])) - jnp.exp(jnp.sum(lam_p[2] * lam_p[3])) + lam_init
    scale = DA_HD ** -0.5
    k_all = jnp.concatenate([kl, kc], axis=1)
    v_all = jnp.concatenate([vl, vc], axis=1)

    def attend(q, k, v):
        s = jnp.einsum('bqhmd,bkhmd->bhmqk', q, k).astype(jnp.float32) * scale
        p = jax.nn.softmax(s, axis=-1)
        a = p[:, :, 0] - lam * p[:, :, 1]
        o = jnp.einsum('bhqk,bkhe->bqhe', a, v.astype(jnp.float32))
        return rmsnorm(o, lp['da_subln_g'], eps=DA_SUBLN_EPS) * (1.0 - lam_init)
    nb = seq // DA_BLOCK
    qb = jnp.moveaxis(ql.reshape(bsz, nb, DA_BLOCK, DA_HEADS, 2, DA_HD), 1, 0)
    ol = lax.map(lambda qblk: attend(qblk, k_all, v_all), qb)
    out_l = jnp.moveaxis(ol, 0, 1).reshape(bsz, seq, DA_W)
    out_c = attend(qc, kc, vc).reshape(bsz, pc.shape[1], DA_W) if ctx_out else None
    return out_l, out_c


def neighbourhood_attention(pl, pc, lp, ctx_out):
    bsz, seq, _ = pl.shape
    rows = seq // GRID_W
    wr = min(NA_WIN_R, rows)

    def qkv(p):
        sh = (p.shape[0], p.shape[1], NA_HEADS, NA_HD)
        return tuple(t.reshape(sh) for t in _split(p, (NA_W, NA_W, NA_W)))
    ql, kl, vl = qkv(pl)
    qc, kc, vc = qkv(pc)
    scale = NA_HD ** -0.5
    rpb = lp['na_rpb'].astype(jnp.float32)
    qg = ql.reshape(bsz, rows, GRID_W, NA_HEADS, NA_HD)
    r_ids = jnp.arange(rows)
    row_start = jnp.clip(r_ids - wr // 2, 0, rows - wr)
    row_idx = row_start[:, None] + jnp.arange(wr)
    kr = kl.reshape(bsz, rows, GRID_W, NA_HEADS, NA_HD)[:, row_idx]
    vr = vl.reshape(bsz, rows, GRID_W, NA_HEADS, NA_HD)[:, row_idx]
    s_win = jnp.einsum('brqhd,brwkhd->bhrqwk', qg, kr).astype(jnp.float32) * scale
    c_ids = jnp.arange(GRID_W)
    col_start = jnp.clip(c_ids - NA_WIN_C // 2, 0, GRID_W - NA_WIN_C)
    in_win = (c_ids[None, :] >= col_start[:, None]) & (c_ids[None, :] < col_start[:, None] + NA_WIN_C)
    ri = row_idx - r_ids[:, None] + NA_WIN_R - 1
    ci = jnp.clip(c_ids[None, :] - c_ids[:, None], -(NA_WIN_C - 1), NA_WIN_C - 1) + NA_WIN_C - 1
    bias = rpb[:, ri[:, None, :, None], ci[None, :, None, :]]
    s_win = jnp.where(in_win[:, None, :], s_win + bias, -jnp.inf)
    s_ctx = jnp.einsum('brqhd,bkhd->bhrqk', qg, kc).astype(jnp.float32) * scale
    n_win = wr * GRID_W
    s = jnp.concatenate([s_win.reshape(bsz, NA_HEADS, rows, GRID_W, n_win), s_ctx], axis=-1)
    p = jax.nn.softmax(s, axis=-1)
    p_win = p[..., :n_win].reshape(bsz, NA_HEADS, rows, GRID_W, wr, GRID_W)
    p_ctx = p[..., n_win:]
    o = (jnp.einsum('bhrqwk,brwkhd->brqhd', p_win, vr.astype(jnp.float32))
         + jnp.einsum('bhrqk,bkhd->brqhd', p_ctx, vc.astype(jnp.float32)))
    out_l = o.reshape(bsz, seq, NA_W)
    out_c = None
    if ctx_out:
        sc = jnp.einsum('bqhd,bkhd->bhqk', qc, kc).astype(jnp.float32) * scale
        oc = jnp.einsum('bhqk,bkhd->bqhd', jax.nn.softmax(sc, axis=-1), vc.astype(jnp.float32))
        out_c = oc.reshape(bsz, pc.shape[1], NA_W)
    return out_l, out_c


def gated_merge(h, branches, lp):
    merged = None
    for n, o in enumerate(branches):
        gate = jax.nn.sigmoid(h @ lp['w_gate'][n] + lp['gate_b'][n])
        term = gate * (o.astype(h.dtype) @ lp['w_br'][n])
        merged = term if merged is None else merged + term
    return merged @ lp['w_out']


def token_mixing(hl, hc, lp, layer_idx, ctx_out):
    zl = _split(hl @ lp['w_in'], IN_SIZES)
    zc = _split(hc @ lp['w_in'], IN_SIZES)
    a_l, a_c = rwkv7_mixer(zl[0], zc[0], lp, ctx_out)
    b_l, b_c = ssd_mixer(zl[1], zc[1], lp, ctx_out)
    c_l, c_c = diff_attention(zl[2], zc[2], lp, layer_idx, ctx_out)
    d_l, d_c = neighbourhood_attention(zl[3], zc[3], lp, ctx_out)
    out_l = gated_merge(hl, (a_l, b_l, c_l, d_l), lp)
    out_c = gated_merge(hc, (a_c, b_c, c_c, d_c), lp) if ctx_out else None
    return out_l, out_c


def conv_ffn(h, up, conv_w, conv_b, down):
    u = dwconv_centred(h @ up, conv_w, conv_b)
    gate, val = jnp.split(u, 2, axis=-1)
    return (jax.nn.silu(gate) * val) @ down


def setup_inputs(seed: int = 0) -> dict:
    key = jax.random.key(seed)
    ks = iter(jax.random.split(key, 48))
    nrm = lambda shape, s: jax.random.normal(next(ks), shape, jnp.float32) * s
    uni = lambda shape, lo, hi: jax.random.uniform(next(ks), shape, jnp.float32, lo, hi)
    dp = DEPTH
    dt0 = jnp.exp(uni((dp, 2, SSD_HEADS), math.log(1e-3), math.log(1e-1)))
    return {
        'x': nrm((BATCH, SEQ, D_MODEL), 1.0),
        'c': nrm((BATCH, D_MODEL), 1.0),
        'ctx': nrm((BATCH, CTX_LEN, D_MODEL), 1.0),
        'c_ctx': nrm((D_MODEL,), 1.0),
        'ada_w': nrm((dp, D_MODEL, 6 * D_MODEL), 0.5 * D_MODEL ** -0.5),
        'ada_b': nrm((dp, 6 * D_MODEL), 0.02),
        'norm1_g': 1.0 + nrm((dp, D_MODEL), 0.05),
        'norm2_g': 1.0 + nrm((dp, D_MODEL), 0.05),
        'w_in': nrm((dp, D_MODEL, IN_TOTAL), D_MODEL ** -0.5),
        'rw_mu': uni((dp, 2, RW_IN), 0.0, 0.5),
        'rw_w0': uni((dp, 2, RW_W), -5.0, -0.5),
        'rw_w_up': nrm((dp, 2, RW_DECAY_RANK, RW_W), 0.5 * RW_DECAY_RANK ** -0.5),
        'rw_a0': nrm((dp, 2, RW_W), 0.5),
        'rw_a_up': nrm((dp, 2, RW_ICLR_RANK, RW_W), RW_ICLR_RANK ** -0.5),
        'rw_g_up': nrm((dp, RW_GATE_RANK, RW_W), RW_GATE_RANK ** -0.5),
        'rw_k_k': 0.85 + nrm((dp, RW_W), 0.05),
        'rw_k_a': 1.0 + nrm((dp, RW_W), 0.05),
        'rw_r_k': nrm((dp, RW_HEADS, RW_HD), 0.1),
        'rw_ln_g': 1.0 + nrm((dp, RW_W), 0.05),
        'rw_ln_b': nrm((dp, RW_W), 0.02),
        'ssd_conv_w': nrm((dp, SSD_CONV, SSD_XBC), SSD_CONV ** -0.5),
        'ssd_conv_b': nrm((dp, SSD_XBC), 0.02),
        'ssd_dt_bias': dt0 + jnp.log(-jnp.expm1(-dt0)),
        'ssd_a_log': jnp.log(uni((dp, 2, SSD_HEADS), 1.0, 16.0)),
        'ssd_d': 1.0 + nrm((dp, SSD_HEADS), 0.1),
        'ssd_norm_g': 1.0 + nrm((dp, SSD_W), 0.05),
        'da_lambda': nrm((dp, 4, DA_HD), 0.1),
        'da_subln_g': 1.0 + nrm((dp, 2 * DA_HD), 0.05),
        'na_rpb': nrm((dp, NA_HEADS, 2 * NA_WIN_R - 1, 2 * NA_WIN_C - 1), 0.02),
        'w_gate': nrm((dp, N_BRANCH, D_MODEL, D_MODEL), D_MODEL ** -0.5),
        'gate_b': nrm((dp, N_BRANCH, D_MODEL), 0.02),
        'w_br': nrm((dp, N_BRANCH, BR_W, D_MODEL), BR_W ** -0.5),
        'w_out': nrm((dp, D_MODEL, D_MODEL), D_MODEL ** -0.5),
        'ffn_up': nrm((dp, D_MODEL, 2 * D_FF), D_MODEL ** -0.5),
        'ffn_conv_w': nrm((dp, FFN_CONV, 2 * D_FF), FFN_CONV ** -0.5),
        'ffn_conv_b': nrm((dp, 2 * D_FF), 0.02),
        'ffn_down': nrm((dp, D_FF, D_MODEL), D_FF ** -0.5),
        'final_norm_g': 1.0 + nrm((D_MODEL,), 0.05),
    }


def reference(x, c, ctx, c_ctx, ada_w, ada_b, norm1_g, norm2_g, w_in, rw_mu, rw_w0, rw_w_up,
              rw_a0, rw_a_up, rw_g_up, rw_k_k, rw_k_a, rw_r_k, rw_ln_g, rw_ln_b, ssd_conv_w,
              ssd_conv_b, ssd_dt_bias, ssd_a_log, ssd_d, ssd_norm_g, da_lambda, da_subln_g, na_rpb,
              w_gate, gate_b, w_br, w_out, ffn_up, ffn_conv_w, ffn_conv_b, ffn_down, final_norm_g):
    xl, xc = x, ctx
    for i in range(DEPTH):
        last = i == DEPTH - 1
        lp = {
            'w_in': w_in[i], 'rw_mu': rw_mu[i], 'rw_w0': rw_w0[i], 'rw_w_up': rw_w_up[i],
            'rw_a0': rw_a0[i], 'rw_a_up': rw_a_up[i], 'rw_g_up': rw_g_up[i], 'rw_k_k': rw_k_k[i],
            'rw_k_a': rw_k_a[i], 'rw_r_k': rw_r_k[i], 'rw_ln_g': rw_ln_g[i], 'rw_ln_b': rw_ln_b[i],
            'ssd_conv_w': ssd_conv_w[i], 'ssd_conv_b': ssd_conv_b[i], 'ssd_dt_bias': ssd_dt_bias[i],
            'ssd_a_log': ssd_a_log[i], 'ssd_d': ssd_d[i], 'ssd_norm_g': ssd_norm_g[i],
            'da_lambda': da_lambda[i], 'da_subln_g': da_subln_g[i], 'na_rpb': na_rpb[i],
            'w_gate': w_gate[i], 'gate_b': gate_b[i], 'w_br': w_br[i], 'w_out': w_out[i],
        }
        mod_l = jax.nn.silu(c) @ ada_w[i] + ada_b[i]
        mod_c = jax.nn.silu(c_ctx) @ ada_w[i] + ada_b[i]
        ml = jnp.split(mod_l[:, None, :], 6, axis=-1)
        mc = jnp.split(mod_c[None, None, :], 6, axis=-1)
        hl = rmsnorm(xl, norm1_g[i]) * (1.0 + ml[1]) + ml[0]
        hc = rmsnorm(xc, norm1_g[i]) * (1.0 + mc[1]) + mc[0]
        ol, oc = token_mixing(hl, hc, lp, i, not last)
        xl = xl + ml[2] * ol
        hl2 = rmsnorm(xl, norm2_g[i]) * (1.0 + ml[4]) + ml[3]
        xl = xl + ml[5] * conv_ffn(hl2, ffn_up[i], ffn_conv_w[i], ffn_conv_b[i], ffn_down[i])
        if not last:
            xc = xc + mc[2] * oc
            hc2 = rmsnorm(xc, norm2_g[i]) * (1.0 + mc[4]) + mc[3]
            xc = xc + mc[5] * conv_ffn(hc2, ffn_up[i], ffn_conv_w[i], ffn_conv_b[i], ffn_down[i])
    return rmsnorm(xl, final_norm_g)
```

```cpp
#include <hip/hip_runtime.h>
#include <hip/hip_cooperative_groups.h>
#include <cstdio>
namespace cg = cooperative_groups;

#define LAS __attribute__((address_space(3)))
#define CAS __attribute__((address_space(4)))
typedef unsigned short bf16_t;
typedef short bf16x8 __attribute__((ext_vector_type(8)));
typedef float f32x2 __attribute__((ext_vector_type(2)));
typedef float f32x4 __attribute__((ext_vector_type(4)));
typedef float f32x8 __attribute__((ext_vector_type(8)));
typedef float f32x16 __attribute__((ext_vector_type(16)));
typedef unsigned u32x2 __attribute__((ext_vector_type(2)));
typedef unsigned u32x4 __attribute__((ext_vector_type(4)));

constexpr int T = 18432, TL = 16384, TC = 2048, DM = 2048, NTHR = 512;
constexpr int ZLD = 6912, Z_RW = 0, Z_SSD = 2048, Z_DA = 3840, Z_NA = 5376;
constexpr int DFF = 5632;
constexpr int LDS_BYTES = 131072;

constexpr size_t OFF_CTL = 0;
constexpr size_t OFF_MOD = 4096;
constexpr size_t MOD_BYTES = 2ull * 9 * 12288 * 4;
constexpr size_t OFF_ROPE = OFF_MOD + MOD_BYTES;
constexpr size_t OFF_XSC = 1048576;
constexpr size_t OFF_WT = OFF_XSC + (size_t)TC * DM * 4;
constexpr size_t WT_BYTES = 2ull * T * 512 * 4;
constexpr size_t WT_WIN = 0;
constexpr size_t WT_WG = 0, WT_WBR = WT_WG + 8192ull * 2048 * 2, WT_WOUT = WT_WBR + 4ull * 2048 * 512 * 2;
constexpr size_t WT_WUP = 0, WT_WDN = WT_WUP + 11264ull * 2048 * 2;
constexpr size_t OFF_OBUF = OFF_WT, OFF_YBUF = OFF_WT + (size_t)T * 512 * 4;
constexpr size_t OFF_H = OFF_WT + WT_BYTES;
constexpr size_t OFF_BIG = OFF_H + (size_t)T * DM * 2;
constexpr size_t B_Z = 0;
constexpr size_t B_RWS = B_Z + (size_t)T * ZLD * 2;
constexpr size_t B_RWD = B_RWS + (size_t)T * 1536 * 4;
constexpr size_t B_XACT = B_RWD + 2ull * T * 1536 * 4;
constexpr size_t B_DTV = B_XACT + (size_t)T * 1024 * 4;
constexpr size_t B_VTDA = B_DTV + (size_t)T * 32 * 4;
constexpr size_t B_VTNA = B_VTDA + 8ull * 512 * 2304 * 2;
constexpr size_t B_BR = B_VTDA;
constexpr size_t B_GBUF = B_BR + 4ull * T * 512 * 2;
constexpr size_t B_END = B_GBUF + (size_t)T * 512 * 2;
constexpr size_t B_GATES = B_RWS;
constexpr size_t B_M32 = B_Z;
constexpr size_t B_M16 = B_Z + (size_t)T * DM * 4;
constexpr size_t B_U = 0;
constexpr size_t B_ACT = (size_t)T * 11264 * 2;
constexpr size_t WS_END = OFF_BIG + B_END;
static_assert(B_VTNA + 8ull * 512 * 2304 * 2 == B_BR + 2ull * T * 512 * 2, "branch/Vt alias");
static_assert(B_GATES + (size_t)T * 8192 * 2 <= B_XACT, "gates alias");
static_assert(B_M16 + (size_t)T * DM * 2 <= B_RWS, "merged alias");
static_assert(B_ACT + (size_t)T * DFF * 2 <= B_BR, "act alias");
static_assert(WT_WDN + 2048ull * 5632 * 2 <= WT_BYTES && WT_WOUT + 2048ull * 2048 * 2 <= WT_BYTES && (size_t)ZLD * 2048 * 2 <= WT_BYTES, "weights fit");
static_assert(WS_END <= 940038528ull, "workspace budget");

struct Params;
typedef const CAS Params& PRef;
struct Params {
  const float *x, *c, *ctx, *c_ctx, *ada_w, *ada_b, *norm1_g, *norm2_g, *w_in, *rw_mu, *rw_w0, *rw_w_up, *rw_a0, *rw_a_up, *rw_g_up, *rw_k_k, *rw_k_a,
      *rw_r_k, *rw_ln_g, *rw_ln_b, *ssd_conv_w, *ssd_conv_b, *ssd_dt_bias, *ssd_a_log, *ssd_d, *ssd_norm_g, *da_lambda, *da_subln_g, *na_rpb, *w_gate,
      *gate_b, *w_br, *w_out, *ffn_up, *ffn_conv_w, *ffn_conv_b, *ffn_down, *final_norm_g;
  float* out;
  unsigned char* ws;
};

__device__ __forceinline__ unsigned opaque_tid() { unsigned t = threadIdx.x; asm volatile("" : "+v"(t)); return t; }
__device__ __forceinline__ unsigned cvt_pk_bf16(float lo, float hi) { unsigned r; asm volatile("v_cvt_pk_bf16_f32 %0, %1, %2" : "=v"(r) : "v"(lo), "v"(hi)); return r; }
__device__ __forceinline__ float bf2f(bf16_t v) { return __uint_as_float((unsigned)v << 16); }
__device__ __forceinline__ float bflo(unsigned v) { return __uint_as_float(v << 16); }
__device__ __forceinline__ float bfhi(unsigned v) { return __uint_as_float(v & 0xffff0000u); }
__device__ __forceinline__ float sigmoidf_(float x) { return 1.0f / (1.0f + __expf(-x)); }
__device__ __forceinline__ float siluf_(float x) { return x / (1.0f + __expf(-x)); }
__device__ __forceinline__ float softplusf_(float x) { return x > 20.f ? x : log1pf(expf(x)); }
__device__ __forceinline__ float wave_sum(float v) {
#pragma unroll
  for (int o = 32; o > 0; o >>= 1) v += __shfl_xor(v, o);
  return v;
}
__device__ __forceinline__ void seq_bounds(int row, int& s0, int& s1) {
  if (row < TL) { s0 = row & ~2047; s1 = s0 + 2048; } else { s0 = TL + ((row - TL) & ~255); s1 = s0 + 256; }
}
namespace pg8 {
#define PG8_LAS __attribute__((address_space(3)))
constexpr int BM = 256, BK = 64, HALF = 128, HTB = HALF * BK * 2, STAGE_BYTES = 8 * HTB, NXCD = 8, WGM = 8;
__host__ __device__ __forceinline__ int lds_byte(int r, int c) { const int st = (r >> 4) * 2 + (c >> 5), rr = r & 15, cc = c & 31, ob = rr * 64 + cc * 2; return st * 1024 + (ob ^ (((ob >> 9) & 1) << 5)); }
__host__ __device__ __forceinline__ void stage_rc(int b, int& R, int& C) { const int st = b / 1024, sb = b % 1024, swz = sb ^ (((sb >> 9) & 1) << 5); R = (st >> 1) * 16 + swz / 64; C = (st & 1) * 32 + (swz % 64) / 2; }
__host__ __device__ __forceinline__ int perm32(int rho) { const int n = rho >> 4, i = rho & 15; return 8 * (i >> 2) + 4 * n + (i & 3); }
struct Unit { int pm, pn; };
struct Gemm { const bf16_t* A; const bf16_t* Bt; int M, N, K; };
struct Sched {
    int nM, nN, nwg, G, c, rep, pm_stride, pn_stride;
    __device__ void init(int M, int N, int G_, int c_, int rep_ = 1, int pms = 0, int pns = 0) { nM = M / BM; nN = N / BM; nwg = nM * nN; G = G_; c = c_; rep = rep_; pm_stride = pms; pn_stride = pns; }
    __device__ bool next(int i, Unit& u) const {
        const int ti = i / rep, sub = i - ti * rep;
        const long L = (long)ti * G + c; if (L >= nwg) return false;
        int wgid = (int)L; { const int q = nwg / NXCD, r = nwg % NXCD, xcd = wgid % NXCD, off = wgid / NXCD; wgid = (xcd < r ? xcd * (q + 1) : r * (q + 1) + (xcd - r) * q) + off; }
        const int nig = WGM * nN, gid = wgid / nig, fm = gid * WGM, gsz = (nM - fm) < WGM ? (nM - fm) : WGM;
        u.pm = fm + ((wgid % nig) % gsz) + sub * pm_stride; u.pn = (wgid % nig) / gsz + sub * pn_stride; return true;
    }
    __device__ __forceinline__ void a_ready(const Unit&) const {}
    __device__ __forceinline__ void done(const Unit&) const {}
};
template <class Epi, class Sched>
__device__ __forceinline__ void gemm_phase(PG8_LAS unsigned char* lds, const Gemm g, const Sched& S, const Epi& E) {
  const unsigned tid_x = opaque_tid();
    const int tid = tid_x, wid = __builtin_amdgcn_readfirstlane(tid >> 6), lane = tid & 63, wr = wid >> 2, wc = wid & 3, fr = lane & 15, fq = lane >> 4;
    const int K = g.K, nt = K / BK;
    unsigned voffA[2], voffB[2];
#pragma unroll
    for (int i = 0; i < 2; ++i) { int R, C; stage_rc(tid * 16 + i * 8192, R, C); const int Rb = Epi::PERM ? ((R & ~31) + perm32(R & 31)) : R;
        voffA[i] = (unsigned)(R * K + C) * 2u; voffB[i] = (unsigned)(Rb * K + C) * 2u; }
    const size_t kstep = (size_t)(BK * 2);
    const size_t hstep = (size_t)HALF * K * 2;
    const size_t tstep = 2 * hstep;
    const unsigned ldsw = (unsigned)wid * 1024u;
    const int aoff = lds_byte(wr * 64 + fr, fq * 8), boff = lds_byte(wc * 32 + fr, fq * 8);
#define PG8_SA(b, h) (((b) * 2 + (h)) * HTB)
#define PG8_SB(b, h) ((4 + (b) * 2 + (h)) * HTB)
#define PG8_STAGE(bufoff, gbase, voff) do { _Pragma("unroll") for (int _i = 0; _i < 2; ++_i) \
        __builtin_amdgcn_global_load_lds((const unsigned*)((const char*)(gbase) + (voff)[_i]), (PG8_LAS unsigned*)(lds + (bufoff) + ldsw + _i * 8192), 16, 0, 0); } while (0)
#define PG8_LDA(dst, b, h) do { _Pragma("unroll") for (int m = 0; m < 4; ++m) _Pragma("unroll") for (int k = 0; k < 2; ++k) dst[m][k] = *(const PG8_LAS bf16x8*)(lds + PG8_SA(b, h) + aoff + m * 2048 + k * 1024); } while (0)
#define PG8_LDB(dst, b, h) do { _Pragma("unroll") for (int n = 0; n < 2; ++n) _Pragma("unroll") for (int k = 0; k < 2; ++k) dst[n][k] = *(const PG8_LAS bf16x8*)(lds + PG8_SB(b, h) + boff + n * 2048 + k * 1024); } while (0)
#define PG8_MMA(ai, bj, At, Bt) do { __builtin_amdgcn_s_setprio(1); _Pragma("unroll") for (int m = 0; m < 4; ++m) _Pragma("unroll") for (int n = 0; n < 2; ++n) _Pragma("unroll") for (int k = 0; k < 2; ++k) \
        acc[ai][bj][m][n] = __builtin_amdgcn_mfma_f32_16x16x32_bf16(Bt[n][k], At[m][k], acc[ai][bj][m][n], 0, 0, 0); __builtin_amdgcn_s_setprio(0); } while (0)
#define PG8_WAIT_V(n) asm volatile("s_waitcnt vmcnt(" #n ")" ::: "memory")
#define PG8_WAIT_L(n) asm volatile("s_waitcnt lgkmcnt(" #n ")" ::: "memory")
#define PG8_BAR __builtin_amdgcn_s_barrier()
#define PG8_SCHED __builtin_amdgcn_sched_barrier(0)
    Unit cur, nxt; int ui = 0;
    if (!S.next(0, cur)) return;
    f32x4 acc[2][2][4][2];
#pragma unroll
    for (int a = 0; a < 2; ++a)
#pragma unroll
        for (int b = 0; b < 2; ++b)
#pragma unroll
            for (int m = 0; m < 4; ++m)
#pragma unroll
                for (int n = 0; n < 2; ++n) acc[a][b][m][n] = (f32x4){0.f, 0.f, 0.f, 0.f};
    bf16x8 At[4][2], B0[2][2], B1[2][2];
    const char* cA = (const char*)g.A + (size_t)cur.pm * tstep; const char* cB = (const char*)g.Bt + (size_t)cur.pn * tstep;
    S.a_ready(cur);
    PG8_STAGE(PG8_SB(0, 0), cB, voffB); PG8_STAGE(PG8_SA(0, 0), cA, voffA); PG8_STAGE(PG8_SB(0, 1), cB + hstep, voffB); PG8_STAGE(PG8_SA(0, 1), cA + hstep, voffA);
    if (wr == 1) PG8_BAR;
    PG8_WAIT_V(4); PG8_BAR;
    PG8_STAGE(PG8_SB(1, 0), cB + kstep, voffB); PG8_STAGE(PG8_SA(1, 0), cA + kstep, voffA); PG8_STAGE(PG8_SB(1, 1), cB + hstep + kstep, voffB);
    PG8_WAIT_V(6); PG8_BAR;
    for (;;) {
        const bool has_next = S.next(ui + 1, nxt);
        const char* nA = has_next ? (const char*)g.A + (size_t)nxt.pm * tstep : cA; const char* nB = has_next ? (const char*)g.Bt + (size_t)nxt.pn * tstep : cB;
        for (int t = 0; t < nt; t += 2) {
            const bool last = (t == nt - 2);
            const char* a1 = cA + (size_t)(t + 1) * kstep;
            const char* a2 = last ? nA : cA + (size_t)(t + 2) * kstep; const char* b2 = last ? nB : cB + (size_t)(t + 2) * kstep;
            const char* a3 = a2 + kstep; const char* b3 = b2 + kstep;
            if (last && has_next) S.a_ready(nxt);
            PG8_LDB(B0, 0, 0); PG8_SCHED; PG8_LDA(At, 0, 0); PG8_STAGE(PG8_SA(1, 1), a1 + hstep, voffA);
            PG8_WAIT_L(8); PG8_BAR; PG8_WAIT_L(0); PG8_MMA(0, 0, At, B0); PG8_BAR; PG8_SCHED;
            PG8_LDB(B1, 0, 1); PG8_STAGE(PG8_SB(0, 0), b2, voffB);
            PG8_BAR; PG8_WAIT_L(0); PG8_MMA(0, 1, At, B1); PG8_BAR;
            PG8_LDA(At, 0, 1); PG8_STAGE(PG8_SA(0, 0), a2, voffA);
            PG8_BAR; PG8_WAIT_L(0); PG8_MMA(1, 0, At, B0); PG8_BAR; PG8_SCHED;
            PG8_STAGE(PG8_SB(0, 1), b2 + hstep, voffB);
            PG8_WAIT_V(6); PG8_BAR; PG8_MMA(1, 1, At, B1); PG8_BAR;
            PG8_LDB(B0, 1, 0); PG8_SCHED; PG8_LDA(At, 1, 0); PG8_STAGE(PG8_SA(0, 1), a2 + hstep, voffA);
            PG8_WAIT_L(8); PG8_BAR; PG8_WAIT_L(0); PG8_MMA(0, 0, At, B0); PG8_BAR; PG8_SCHED;
            PG8_LDB(B1, 1, 1); PG8_STAGE(PG8_SB(1, 0), b3, voffB);
            PG8_BAR; PG8_WAIT_L(0); PG8_MMA(0, 1, At, B1); PG8_BAR;
            PG8_LDA(At, 1, 1); PG8_STAGE(PG8_SA(1, 0), a3, voffA);
            PG8_BAR; PG8_WAIT_L(0); PG8_MMA(1, 0, At, B0); PG8_BAR; PG8_SCHED;
            PG8_STAGE(PG8_SB(1, 1), b3 + hstep, voffB);
            PG8_WAIT_V(6); PG8_BAR; PG8_MMA(1, 1, At, B1); PG8_BAR;
        }
        if constexpr (!Epi::AFTER_DRAIN) { E(acc, cur, wr, wc, fr, fq); S.done(cur); }
        if (!has_next) break;
#pragma unroll
        for (int a = 0; a < 2; ++a)
#pragma unroll
            for (int b = 0; b < 2; ++b)
#pragma unroll
                for (int m = 0; m < 4; ++m)
#pragma unroll
                    for (int n = 0; n < 2; ++n) acc[a][b][m][n] = (f32x4){0.f, 0.f, 0.f, 0.f};
        cur = nxt; cA = nA; cB = nB; ++ui;
    }
    PG8_WAIT_V(0);
    if (wr == 0) PG8_BAR;
    PG8_BAR;
    if constexpr (Epi::AFTER_DRAIN) { E.fused(acc, cur, wr, wc, fr, fq, lds, wid, lane); S.done(cur); }
#undef PG8_SA
#undef PG8_SB
#undef PG8_STAGE
#undef PG8_LDA
#undef PG8_LDB
#undef PG8_MMA
#undef PG8_WAIT_V
#undef PG8_WAIT_L
#undef PG8_BAR
#undef PG8_SCHED
}
}


using pg8::Unit;
typedef f32x4 AccT[2][2][4][2];

struct EpiZ {
  static constexpr bool PERM = false, AFTER_DRAIN = false;
  bf16_t* Z; const float* ropeC; const float* ropeS;
  __device__ __forceinline__ void operator()(const AccT& acc, const Unit& u, int wr, int wc, int fr, int fq) const {
    const int row0 = u.pm * 256 + wr * 64 + fr, col0 = u.pn * 256 + wc * 32 + 4 * fq;
    const bool rope = (u.pn >= 15 && u.pn <= 18 && u.pm < 64);
#pragma unroll
    for (int ai = 0; ai < 2; ++ai)
#pragma unroll
      for (int m = 0; m < 4; ++m) {
        const int row = row0 + ai * 128 + m * 16;
        bf16_t* rowp = Z + (size_t)row * ZLD + col0;
        f32x4 cs = {1.f, 1.f, 1.f, 1.f}, sn = {0.f, 0.f, 0.f, 0.f};
        if (rope) { const int t = row & 2047; const int pos = (wc & 1) ? (t & 63) : (t >> 6); cs = *(const f32x4*)(ropeC + pos * 16 + 4 * fq); sn = *(const f32x4*)(ropeS + pos * 16 + 4 * fq); }
#pragma unroll
        for (int bj = 0; bj < 2; ++bj) {
          f32x4 x1 = acc[ai][bj][m][0], x2 = acc[ai][bj][m][1];
          if (rope) { const f32x4 o1 = x1 * cs - x2 * sn, o2 = x2 * cs + x1 * sn; x1 = o1; x2 = o2; }
          u32x2 w1, w2; w1.x = cvt_pk_bf16(x1[0], x1[1]); w1.y = cvt_pk_bf16(x1[2], x1[3]); w2.x = cvt_pk_bf16(x2[0], x2[1]); w2.y = cvt_pk_bf16(x2[2], x2[3]);
          *(u32x2*)(rowp + bj * 128) = w1; *(u32x2*)(rowp + bj * 128 + 16) = w2;
        }
      }
  }
};

template <int ACT> struct EpiBf16 {
  static constexpr bool PERM = true, AFTER_DRAIN = false;
  bf16_t* O; int ldc; const float* bias;
  __device__ __forceinline__ void operator()(const AccT& acc, const Unit& u, int wr, int wc, int fr, int fq) const {
    const int row0 = u.pm * 256 + wr * 64 + fr, col0 = u.pn * 256 + wc * 32 + 8 * fq;
    f32x4 bv[2][2];
#pragma unroll
    for (int bj = 0; bj < 2; ++bj)
#pragma unroll
      for (int n = 0; n < 2; ++n) bv[bj][n] = bias ? *(const f32x4*)(bias + col0 + bj * 128 + 4 * n) : (f32x4){0.f, 0.f, 0.f, 0.f};
#pragma unroll
    for (int ai = 0; ai < 2; ++ai)
#pragma unroll
      for (int m = 0; m < 4; ++m) {
        bf16_t* rowp = O + (size_t)(row0 + ai * 128 + m * 16) * ldc + col0;
#pragma unroll
        for (int bj = 0; bj < 2; ++bj) {
          f32x4 v0 = acc[ai][bj][m][0] + bv[bj][0], v1 = acc[ai][bj][m][1] + bv[bj][1];
          if (ACT == 1) {
#pragma unroll
            for (int j = 0; j < 4; ++j) { v0[j] = sigmoidf_(v0[j]); v1[j] = sigmoidf_(v1[j]); }
          }
          u32x4 w; w.x = cvt_pk_bf16(v0[0], v0[1]); w.y = cvt_pk_bf16(v0[2], v0[3]); w.z = cvt_pk_bf16(v1[0], v1[1]); w.w = cvt_pk_bf16(v1[2], v1[3]);
          *(u32x4*)(rowp + bj * 128) = w;
        }
      }
  }
};

struct EpiMerge {
  static constexpr bool PERM = false, AFTER_DRAIN = false;
  const bf16_t* gates; float* m32; bf16_t* m16;
  __device__ __forceinline__ void operator()(const AccT& acc, const Unit& u, int wr, int wc, int fr, int fq) const {
    const int sub = u.pm / 72, pm = u.pm - sub * 72, pn = u.pn & 7;
    const int row0 = pm * 256 + wr * 64 + fr, col0 = pn * 256 + wc * 32 + 4 * fq;
#pragma unroll
    for (int ai = 0; ai < 2; ++ai)
#pragma unroll
      for (int m = 0; m < 4; ++m) {
        const size_t row = (size_t)(row0 + ai * 128 + m * 16);
        const bf16_t* gp = gates + row * 8192 + sub * 2048 + col0;
        float* mp = m32 + row * 2048 + col0;
        bf16_t* op = m16 + row * 2048 + col0;
#pragma unroll
        for (int bj = 0; bj < 2; ++bj)
#pragma unroll
          for (int n = 0; n < 2; ++n) {
            const u32x2 g = *(const u32x2*)(gp + bj * 128 + n * 16);
            f32x4 v = acc[ai][bj][m][n];
            v[0] *= bflo(g.x); v[1] *= bfhi(g.x); v[2] *= bflo(g.y); v[3] *= bfhi(g.y);
            if (sub > 0) v += *(const f32x4*)(mp + bj * 128 + n * 16);
            if (sub < 3) *(f32x4*)(mp + bj * 128 + n * 16) = v;
            else { u32x2 w; w.x = cvt_pk_bf16(v[0], v[1]); w.y = cvt_pk_bf16(v[2], v[3]); *(u32x2*)(op + bj * 128 + n * 16) = w; }
          }
      }
  }
};

struct EpiRes {
  static constexpr bool PERM = false, AFTER_DRAIN = false;
  const float* old_l; const float* old_c; float* new_l; float* new_c; const float* modg;
  __device__ __forceinline__ void operator()(const AccT& acc, const Unit& u, int wr, int wc, int fr, int fq) const {
    const int rowt = u.pm * 256;
    const bool lat = rowt < TL;
    const float* ob = lat ? old_l + (size_t)rowt * 2048 : old_c + (size_t)(rowt - TL) * 2048;
    float* nb = lat ? new_l + (size_t)rowt * 2048 : new_c + (size_t)(rowt - TL) * 2048;
    const int mrow = lat ? (rowt >> 11) : 8;
    const int r0 = wr * 64 + fr, col0 = u.pn * 256 + wc * 32 + 4 * fq;
    f32x4 mv[2][2];
#pragma unroll
    for (int bj = 0; bj < 2; ++bj)
#pragma unroll
      for (int n = 0; n < 2; ++n) mv[bj][n] = *(const f32x4*)(modg + (size_t)mrow * 12288 + col0 + bj * 128 + n * 16);
#pragma unroll
    for (int ai = 0; ai < 2; ++ai)
#pragma unroll
      for (int m = 0; m < 4; ++m) {
        const size_t off = (size_t)(r0 + ai * 128 + m * 16) * 2048 + col0;
#pragma unroll
        for (int bj = 0; bj < 2; ++bj)
#pragma unroll
          for (int n = 0; n < 2; ++n) {
            const f32x4 o = *(const f32x4*)(ob + off + bj * 128 + n * 16);
            *(f32x4*)(nb + off + bj * 128 + n * 16) = o + mv[bj][n] * acc[ai][bj][m][n];
          }
      }
  }
};
__device__ __forceinline__ void phase_mod(PRef p, LAS unsigned char* lds) {
  const unsigned tid_x = opaque_tid();
  LAS float* sl = (LAS float*)lds;
  float* mod = (float*)(p.ws + OFF_MOD);
  const int tid = tid_x;
  for (int it = blockIdx.x; it < 768; it += gridDim.x) {
    const int layer = it / 384, rem = it % 384, ks = rem / 24, cb = rem % 24, k0 = ks * 128;
    __syncthreads();
    for (int i = tid; i < 9 * 128; i += NTHR) { const int r = i >> 7, k = i & 127; const float v = (r < 8) ? p.c[r * 2048 + k0 + k] : p.c_ctx[k0 + k]; sl[i] = siluf_(v); }
    __syncthreads();
    const int n = cb * 512 + tid;
    const float* W = p.ada_w + (size_t)layer * 2048 * 12288 + (size_t)k0 * 12288 + n;
    float a0 = 0, a1 = 0, a2 = 0, a3 = 0, a4 = 0, a5 = 0, a6 = 0, a7 = 0, a8 = 0;
#pragma unroll 4
    for (int k = 0; k < 128; ++k) {
      const float w = W[(size_t)k * 12288];
      a0 += sl[k] * w; a1 += sl[128 + k] * w; a2 += sl[256 + k] * w; a3 += sl[384 + k] * w; a4 += sl[512 + k] * w;
      a5 += sl[640 + k] * w; a6 += sl[768 + k] * w; a7 += sl[896 + k] * w; a8 += sl[1024 + k] * w;
    }
    const float bias = ks == 0 ? p.ada_b[layer * 12288 + n] : 0.f;
    float* dst = mod + (size_t)layer * 9 * 12288 + n;
    atomicAdd(dst + 0 * 12288, a0 + bias); atomicAdd(dst + 1 * 12288, a1 + bias); atomicAdd(dst + 2 * 12288, a2 + bias);
    atomicAdd(dst + 3 * 12288, a3 + bias); atomicAdd(dst + 4 * 12288, a4 + bias); atomicAdd(dst + 5 * 12288, a5 + bias);
    atomicAdd(dst + 6 * 12288, a6 + bias); atomicAdd(dst + 7 * 12288, a7 + bias); atomicAdd(dst + 8 * 12288, a8 + bias);
  }
  if (blockIdx.x == gridDim.x - 1) {
    float* rc = (float*)(p.ws + OFF_ROPE); float* rs = rc + 1024;
    for (int i = tid; i < 1024; i += NTHR) {
      const int pos = i >> 4, f = i & 15;
      const float inv = exp2f(-(float)f * (13.287712379549449f / 16.0f));
      const float angf = (float)pos * inv;
      const double x = (double)angf;
      const double kq = rint(x * 0.15915494309189535);
      const double r = x - kq * 6.283185307179586476925;
      const double r2 = r * r;
      double s = r, c = 1.0, ts = r, tc = 1.0;
#pragma unroll 1
      for (int j = 1; j <= 14; ++j) { tc *= -r2 / (double)((2 * j - 1) * (2 * j)); ts *= -r2 / (double)((2 * j) * (2 * j + 1)); c += tc; s += ts; }
      rc[i] = (float)c; rs[i] = (float)s;
    }
  }
}

__device__ __forceinline__ void conv_tile(const float* src, int ld, int K, int col0, int ncols, bf16_t* dst, int kt, int nt, LAS float* tile) {
  const unsigned tid_x = opaque_tid();
  const int tid = tid_x;
  __syncthreads();
#pragma unroll
  for (int i = tid; i < 1024; i += NTHR) {
    const int kr = i >> 4, c4 = (i & 15) * 4;
    f32x4 v = {0.f, 0.f, 0.f, 0.f};
    if (nt * 64 + c4 < ncols) v = *(const f32x4*)(src + (size_t)(kt * 64 + kr) * ld + col0 + nt * 64 + c4);
    LAS float* tp = tile + kr * 65 + c4;
    tp[0] = v[0]; tp[1] = v[1]; tp[2] = v[2]; tp[3] = v[3];
  }
  __syncthreads();
  const int nl = tid >> 3, kc = tid & 7;
  float e[8];
#pragma unroll
  for (int j = 0; j < 8; ++j) e[j] = tile[(kc * 8 + j) * 65 + nl];
  u32x4 w; w.x = cvt_pk_bf16(e[0], e[1]); w.y = cvt_pk_bf16(e[2], e[3]); w.z = cvt_pk_bf16(e[4], e[5]); w.w = cvt_pk_bf16(e[6], e[7]);
  *(u32x4*)(dst + (size_t)(nt * 64 + nl) * K + kt * 64 + kc * 8) = w;
}

__device__ __forceinline__ void phase_conv1(PRef p, int layer, LAS unsigned char* lds, int it0, int it1) {
  LAS float* tile = (LAS float*)lds;
  bf16_t* wt = (bf16_t*)(p.ws + OFF_WT);
  const float* win = p.w_in + (size_t)layer * 2048 * 6544;
  for (int it = it0 + blockIdx.x; it < it1; it += gridDim.x) {
    int i = it;
    if (i < 3296) {
      int col0, ncols, drow, ntl;
      if (i < 960) { col0 = 0; ncols = 1920; drow = Z_RW; ntl = 30; }
      else if (i < 1760) { i -= 960; col0 = 1920; ncols = 1552; drow = Z_SSD; ntl = 25; }
      else if (i < 2528) { i -= 1760; col0 = 3472; ncols = 1536; drow = Z_DA; ntl = 24; }
      else { i -= 2528; col0 = 5008; ncols = 1536; drow = Z_NA; ntl = 24; }
      conv_tile(win, 6544, 2048, col0, ncols, wt + WT_WIN / 2 + (size_t)drow * 2048, i / ntl, i % ntl, tile);
    } else if (i < 3296 + 4096) {
      i -= 3296; const int n = i >> 10, j = i & 1023;
      conv_tile(p.w_gate + ((size_t)layer * 4 + n) * 2048 * 2048, 2048, 2048, 0, 2048, wt + WT_WG / 2 + (size_t)n * 2048 * 2048, j >> 5, j & 31, tile);
    } else if (i < 3296 + 4096 + 1024) {
      i -= 7392; const int n = i >> 8, j = i & 255;
      conv_tile(p.w_br + ((size_t)layer * 4 + n) * 512 * 2048, 2048, 512, 0, 2048, wt + WT_WBR / 2 + (size_t)n * 2048 * 512, j >> 5, j & 31, tile);
    } else {
      i -= 8416;
      conv_tile(p.w_out + (size_t)layer * 2048 * 2048, 2048, 2048, 0, 2048, wt + WT_WOUT / 2, i >> 5, i & 31, tile);
    }
  }
}
__device__ __forceinline__ void phase_conv2(PRef p, int layer, LAS unsigned char* lds) {
  LAS float* tile = (LAS float*)lds;
  bf16_t* wt = (bf16_t*)(p.ws + OFF_WT);
  for (int it = blockIdx.x; it < 5632 + 2816; it += gridDim.x) {
    if (it < 5632) conv_tile(p.ffn_up + (size_t)layer * 2048 * 11264, 11264, 2048, 0, 11264, wt + WT_WUP / 2, it / 176, it % 176, tile);
    else { const int i = it - 5632; conv_tile(p.ffn_down + (size_t)layer * 5632 * 2048, 2048, 5632, 0, 2048, wt + WT_WDN / 2, i >> 5, i & 31, tile); }
  }
}

__device__ __forceinline__ void phase_norm(const float* xl, const float* xc, const float* g, const float* modl, int shift_idx, int scale_idx, bf16_t* H, int nrows) {
  const unsigned tid_x = opaque_tid();
  const int wid = tid_x >> 6, lane = tid_x & 63;
  for (int row = blockIdx.x * 8 + wid; row < nrows; row += gridDim.x * 8) {
    const float* xr = row < TL ? xl + (size_t)row * 2048 : xc + (size_t)(row - TL) * 2048;
    const int mrow = row < TL ? (row >> 11) : 8;
    f32x4 v[8]; float ss = 0.f;
#pragma unroll
    for (int i = 0; i < 8; ++i) { v[i] = *(const f32x4*)(xr + (i * 64 + lane) * 4); ss += v[i][0] * v[i][0] + v[i][1] * v[i][1] + v[i][2] * v[i][2] + v[i][3] * v[i][3]; }
    ss = wave_sum(ss);
    const float rs = rsqrtf(ss * (1.0f / 2048.0f) + 1e-6f);
    const float* sh = modl + (size_t)mrow * 12288 + shift_idx * 2048; const float* sc = modl + (size_t)mrow * 12288 + scale_idx * 2048;
#pragma unroll
    for (int i = 0; i < 8; ++i) {
      const int col = (i * 64 + lane) * 4;
      const f32x4 gg = *(const f32x4*)(g + col), s1 = *(const f32x4*)(sc + col), s0 = *(const f32x4*)(sh + col);
      const f32x4 y = (v[i] * rs * gg) * (s1 + 1.0f) + s0;
      u32x2 w; w.x = cvt_pk_bf16(y[0], y[1]); w.y = cvt_pk_bf16(y[2], y[3]);
      *(u32x2*)(H + (size_t)row * 2048 + col) = w;
    }
  }
}

__device__ __forceinline__ void prep_rwkv_tile(PRef p, int layer, int tile, LAS unsigned char* lds) {
  const unsigned tid_x = opaque_tid();
  LAS float* lr = (LAS float*)lds;
  const bf16_t* Z = (const bf16_t*)(p.ws + OFF_BIG + B_Z);
  float* RWS = (float*)(p.ws + OFF_BIG + B_RWS); float* RWD = (float*)(p.ws + OFF_BIG + B_RWD); bf16_t* GB = (bf16_t*)(p.ws + OFF_BIG + B_GBUF);
  const int tid = tid_x, tok0 = tile * 8;
  int s0, s1; seq_bounds(tok0, s0, s1);
  const float* mu = p.rw_mu + (size_t)layer * 2 * 1920;
  __syncthreads();
  if (tid < 384) {
    const int col = 1536 + tid; const float m0 = mu[col], m1 = mu[1920 + col];
    float zp = (tok0 > s0) ? bf2f(Z[(size_t)(tok0 - 1) * ZLD + col]) : 0.f, zc = bf2f(Z[(size_t)tok0 * ZLD + col]);
#pragma unroll 4
    for (int i = 0; i < 8; ++i) {
      const int r = tok0 + i;
      const float zn = (r + 1 < s1) ? bf2f(Z[(size_t)(r + 1) * ZLD + col]) : 0.f;
      const float pv = zc + m0 * (zp - zc) + m1 * (zn - zc);
      lr[i * 384 + tid] = tid < 128 ? tanhf(pv) : (tid < 256 ? pv : sigmoidf_(pv));
      zp = zc; zc = zn;
    }
  }
  __syncthreads();
  const int cg_ = tid & 127, tg = tid >> 7;
  float aw[2][4][2], aa[2][4][2], ag[4][2];
#pragma unroll
  for (int q = 0; q < 4; ++q)
#pragma unroll
    for (int t = 0; t < 2; ++t) { aw[0][q][t] = aw[1][q][t] = aa[0][q][t] = aa[1][q][t] = ag[q][t] = 0.f; }
  const float* wup = p.rw_w_up + (size_t)layer * 2 * 64 * 512; const float* aup = p.rw_a_up + (size_t)layer * 2 * 64 * 512; const float* gup = p.rw_g_up + (size_t)layer * 128 * 512;
#pragma unroll 1
  for (int r = 0; r < 64; r += 4) {
    f32x4 lw[2][2], la[2][2];
#pragma unroll
    for (int t = 0; t < 2; ++t) {
      const LAS float* lp = lr + (tg * 2 + t) * 384 + r;
      lw[0][t] = *(const LAS f32x4*)(lp); lw[1][t] = *(const LAS f32x4*)(lp + 64); la[0][t] = *(const LAS f32x4*)(lp + 128); la[1][t] = *(const LAS f32x4*)(lp + 192);
    }
#pragma unroll
    for (int e = 0; e < 4; ++e)
#pragma unroll
      for (int q = 0; q < 4; ++q) {
        const int c = cg_ + 128 * q;
        const float w0 = wup[(size_t)(r + e) * 512 + c], w1 = wup[(size_t)(64 + r + e) * 512 + c], u0 = aup[(size_t)(r + e) * 512 + c], u1 = aup[(size_t)(64 + r + e) * 512 + c];
#pragma unroll
        for (int t = 0; t < 2; ++t) { aw[0][q][t] += lw[0][t][e] * w0; aw[1][q][t] += lw[1][t][e] * w1; aa[0][q][t] += la[0][t][e] * u0; aa[1][q][t] += la[1][t][e] * u1; }
      }
  }
#pragma unroll 1
  for (int r = 0; r < 128; r += 4) {
    f32x4 lg[2];
#pragma unroll
    for (int t = 0; t < 2; ++t) lg[t] = *(const LAS f32x4*)(lr + (tg * 2 + t) * 384 + 256 + r);
#pragma unroll
    for (int e = 0; e < 4; ++e)
#pragma unroll
      for (int q = 0; q < 4; ++q) {
        const float w = gup[(size_t)(r + e) * 512 + cg_ + 128 * q];
#pragma unroll
        for (int t = 0; t < 2; ++t) ag[q][t] += lg[t][e] * w;
      }
  }
#pragma unroll
  for (int q = 0; q < 4; ++q) {
    const int c = cg_ + 128 * q;
    const float w00 = p.rw_w0[(size_t)layer * 1024 + c], w01 = p.rw_w0[(size_t)layer * 1024 + 512 + c];
    const float a00 = p.rw_a0[(size_t)layer * 1024 + c], a01 = p.rw_a0[(size_t)layer * 1024 + 512 + c];
    const float kkw = p.rw_k_k[layer * 512 + c], kaw = p.rw_k_a[layer * 512 + c];
    const float mr0 = mu[c], mr1 = mu[1920 + c], mk0 = mu[512 + c], mk1 = mu[1920 + 512 + c], mv0 = mu[1024 + c], mv1 = mu[1920 + 1024 + c];
#pragma unroll
    for (int t = 0; t < 2; ++t) {
      const int row = tok0 + tg * 2 + t;
      const bf16_t* zc = Z + (size_t)row * ZLD + c;
      const bool hp = row > s0, hn = row + 1 < s1;
      const float rc = bf2f(zc[0]), kc = bf2f(zc[512]), vc = bf2f(zc[1024]);
      const float rp = hp ? bf2f(zc[-ZLD]) : 0.f, kp = hp ? bf2f(zc[-ZLD + 512]) : 0.f, vp = hp ? bf2f(zc[-ZLD + 1024]) : 0.f;
      const float rn = hn ? bf2f(zc[ZLD]) : 0.f, kn = hn ? bf2f(zc[ZLD + 512]) : 0.f, vn = hn ? bf2f(zc[ZLD + 1024]) : 0.f;
      const float rr = rc + mr0 * (rp - rc) + mr1 * (rn - rc);
      const float kk_ = kc + mk0 * (kp - kc) + mk1 * (kn - kc);
      const float vv = vc + mv0 * (vp - vc) + mv1 * (vn - vc);
      const float kkr = kk_ * kkw;
      const float n2 = wave_sum(kkr * kkr);
      const float kkn = kkr / fmaxf(sqrtf(n2), 1e-12f);
      float* rs = RWS + (size_t)row * 1536 + c;
      rs[0] = rr; rs[512] = vv; rs[1024] = kkn;
      GB[(size_t)row * 512 + c] = (bf16_t)(cvt_pk_bf16(ag[q][t], 0.f) & 0xffffu);
#pragma unroll
      for (int d = 0; d < 2; ++d) {
        const float wraw = (d ? w01 : w00) + aw[d][q][t];
        const float dec = expf(-expf(-softplusf_(-wraw) - 0.5f));
        const float a = sigmoidf_((d ? a01 : a00) + aa[d][q][t]);
        float* rd = RWD + ((size_t)d * T + row) * 1536 + c;
        rd[0] = dec; rd[512] = kk_ * (1.0f + (a - 1.0f) * kaw); rd[1024] = kkn * a;
      }
    }
  }
}

__device__ __forceinline__ void prep_ssd_row(PRef p, int layer, int row) {
  const unsigned tid_x = opaque_tid();
  const bf16_t* Z = (const bf16_t*)(p.ws + OFF_BIG + B_Z);
  float* XA = (float*)(p.ws + OFF_BIG + B_XACT); float* DT = (float*)(p.ws + OFF_BIG + B_DTV);
  const int tid = tid_x;
  int s0, s1; seq_bounds(row, s0, s1);
  const int j = tid * 2;
  const bf16_t* zc = Z + (size_t)row * ZLD + Z_SSD + 512 + j;
  const unsigned c2 = *(const unsigned*)zc;
  const unsigned p2 = row > s0 ? *(const unsigned*)(zc - ZLD) : 0u;
  const unsigned n2 = row + 1 < s1 ? *(const unsigned*)(zc + ZLD) : 0u;
  const float* cw = p.ssd_conv_w + (size_t)layer * 3 * 1024 + j; const float* cb = p.ssd_conv_b + (size_t)layer * 1024 + j;
  const float y0 = cb[0] + cw[0] * bflo(p2) + cw[1024] * bflo(c2) + cw[2048] * bflo(n2);
  const float y1 = cb[1] + cw[1] * bfhi(p2) + cw[1025] * bfhi(c2) + cw[2049] * bfhi(n2);
  *(f32x2*)(XA + (size_t)row * 1024 + j) = (f32x2){siluf_(y0), siluf_(y1)};
  if (tid < 16) {
    const float dr = bf2f(Z[(size_t)row * ZLD + Z_SSD + 1536 + tid]);
    const float dt = softplusf_(dr + p.ssd_dt_bias[layer * 16 + tid]);
    const float a = -expf(p.ssd_a_log[layer * 16 + tid]);
    DT[(size_t)row * 32 + tid] = dt; DT[(size_t)row * 32 + 16 + tid] = expf(dt * a);
  }
}

__device__ __forceinline__ void prep_vt_tile(PRef p, int item, LAS unsigned char* lds) {
  const unsigned tid_x = opaque_tid();
  LAS bf16_t* tl = (LAS bf16_t*)lds;
  const bf16_t* Z = (const bf16_t*)(p.ws + OFF_BIG + B_Z);
  const int which = item / 2304, rem = item % 2304, b = rem / 288, r2 = rem % 288, kt = r2 >> 3, ct = r2 & 7;
  bf16_t* Vt = (bf16_t*)(p.ws + OFF_BIG + (which ? B_VTNA : B_VTDA));
  const int colbase = (which ? Z_NA : Z_DA) + 1024 + ct * 64;
  const int row0 = kt < 32 ? b * 2048 + kt * 64 : TL + b * 256 + (kt - 32) * 64;
  const int tid = tid_x;
  __syncthreads();
  { const int i = tid >> 3, c8 = tid & 7;
    const u32x4 v = *(const u32x4*)(Z + (size_t)(row0 + i) * ZLD + colbase + c8 * 8);
    LAS bf16_t* tp = tl + (c8 * 8) * 72 + i;
    tp[0] = (bf16_t)(v.x & 0xffff); tp[72] = (bf16_t)(v.x >> 16); tp[144] = (bf16_t)(v.y & 0xffff); tp[216] = (bf16_t)(v.y >> 16);
    tp[288] = (bf16_t)(v.z & 0xffff); tp[360] = (bf16_t)(v.z >> 16); tp[432] = (bf16_t)(v.w & 0xffff); tp[504] = (bf16_t)(v.w >> 16); }
  __syncthreads();
  { const int c = tid >> 3, k8 = tid & 7;
    const u32x4 v = *(const LAS u32x4*)(tl + c * 72 + k8 * 8);
    *(u32x4*)(Vt + ((size_t)b * 512 + ct * 64 + c) * 2304 + kt * 64 + k8 * 8) = v; }
}

__device__ __forceinline__ void phase_prep(PRef p, int layer, LAS unsigned char* lds) {
  const unsigned tid_x = opaque_tid();
  const int n_rw = T / 8, n_total = n_rw + 4608;
  for (int it = blockIdx.x; it < n_total; it += gridDim.x) {
    if (it < n_rw) prep_rwkv_tile(p, layer, it, lds); else prep_vt_tile(p, it - n_rw, lds);
  }
  for (int row = blockIdx.x; row < T; row += gridDim.x) prep_ssd_row(p, layer, row);
  f32x4* zz = (f32x4*)(p.ws + OFF_OBUF);
  const size_t n4 = (size_t)T * 512 * 2 / 4;
  for (size_t i = (size_t)blockIdx.x * NTHR + tid_x; i < n4; i += (size_t)gridDim.x * NTHR) zz[i] = (f32x4){0.f, 0.f, 0.f, 0.f};
}
__device__ __forceinline__ int scan_row(int s, int b, int dir) {
  if (s < 256) { const int j = dir ? 255 - s : s; return TL + b * 256 + j; }
  const int t = s - 256; return b * 2048 + (dir ? 2047 - t : t);
}

__device__ __forceinline__ void scan_rwkv(PRef p, int chain, LAS unsigned char* lds) {
  const unsigned tid_x = opaque_tid();
  LAS float* part = (LAS float*)lds;
  LAS float* opart = part + 1024;
  const int b = chain >> 4, h = (chain >> 1) & 7, dir = chain & 1;
  const int wid = __builtin_amdgcn_readfirstlane(tid_x >> 6), lane = tid_x & 63;
  const float* RWS = (const float*)(p.ws + OFF_BIG + B_RWS);
  const float* RWD = (const float*)(p.ws + OFF_BIG + B_RWD) + (size_t)dir * T * 1536;
  float* OB = (float*)(p.ws + OFF_OBUF);
  const CAS float* cS = (const CAS float*)RWS + 64 * h + 8 * wid;
  const CAS float* cD = (const CAS float*)RWD + 64 * h + 8 * wid;
  float S[8];
#pragma unroll
  for (int j = 0; j < 8; ++j) S[j] = 0.f;
  int row = scan_row(0, b, dir);
  f32x8 r_n = *(const CAS f32x8*)(cS + (size_t)row * 1536), kk_n = *(const CAS f32x8*)(cS + (size_t)row * 1536 + 1024);
  f32x8 w_n = *(const CAS f32x8*)(cD + (size_t)row * 1536), kd_n = *(const CAS f32x8*)(cD + (size_t)row * 1536 + 512), b_n = *(const CAS f32x8*)(cD + (size_t)row * 1536 + 1024);
  float v_n = RWS[(size_t)row * 1536 + 512 + 64 * h + lane];
#pragma unroll 1
  for (int s = 0; s < 2304; ++s) {
    const f32x8 r = r_n, kk = kk_n, w = w_n, kd = kd_n, bb = b_n; const float v = v_n;
    const int crow = row;
    if (s + 1 < 2304) {
      row = scan_row(s + 1, b, dir);
      r_n = *(const CAS f32x8*)(cS + (size_t)row * 1536); kk_n = *(const CAS f32x8*)(cS + (size_t)row * 1536 + 1024);
      w_n = *(const CAS f32x8*)(cD + (size_t)row * 1536); kd_n = *(const CAS f32x8*)(cD + (size_t)row * 1536 + 512); b_n = *(const CAS f32x8*)(cD + (size_t)row * 1536 + 1024);
      v_n = RWS[(size_t)row * 1536 + 512 + 64 * h + lane];
    }
    float sp = 0.f;
#pragma unroll
    for (int j = 0; j < 8; ++j) sp += S[j] * kk[j];
    part[(s & 1) * 512 + wid * 64 + lane] = sp;
    __syncthreads();
    float sa = 0.f;
#pragma unroll
    for (int j = 0; j < 8; ++j) sa += part[(s & 1) * 512 + j * 64 + lane];
    float op = 0.f;
#pragma unroll
    for (int j = 0; j < 8; ++j) { S[j] = S[j] * w[j] - sa * bb[j] + v * kd[j]; op += S[j] * r[j]; }
    opart[(s & 15) * 512 + wid * 64 + lane] = op;
    if ((s & 7) == 0 && s >= 8) {
      const int fs = s - 8 + wid;
      float o = 0.f;
#pragma unroll
      for (int j = 0; j < 8; ++j) o += opart[(fs & 15) * 512 + j * 64 + lane];
      const int frow = scan_row(fs, b, dir);
      unsafeAtomicAdd(OB + (size_t)frow * 512 + 64 * h + lane, o);
    }
    (void)crow;
  }
  __syncthreads();
  { const int fs = 2304 - 8 + wid;
    float o = 0.f;
#pragma unroll
    for (int j = 0; j < 8; ++j) o += opart[(fs & 15) * 512 + j * 64 + lane];
    const int frow = scan_row(fs, b, dir);
    unsafeAtomicAdd(OB + (size_t)frow * 512 + 64 * h + lane, o); }
  __syncthreads();
}

__device__ __forceinline__ void scan_ssd(PRef p, int chain, LAS unsigned char* lds) {
  const unsigned tid_x = opaque_tid();
  LAS float* ypart = (LAS float*)lds;
  const int b = chain >> 4, h = (chain >> 1) & 7, dir = chain & 1, g = h >> 2;
  const int wid = __builtin_amdgcn_readfirstlane(tid_x >> 6), lane = tid_x & 63;
  const float* XA = (const float*)(p.ws + OFF_BIG + B_XACT);
  const float* DT = (const float*)(p.ws + OFF_BIG + B_DTV);
  float* YB = (float*)(p.ws + OFF_YBUF);
  const CAS float* cB = (const CAS float*)XA + 512 + 128 * g + 16 * wid;
  const CAS float* cC = (const CAS float*)XA + 768 + 128 * g + 16 * wid;
  const CAS float* cT = (const CAS float*)DT + dir * 8 + h;
  float hs[16];
#pragma unroll
  for (int j = 0; j < 16; ++j) hs[j] = 0.f;
  int row = scan_row(0, b, dir);
  f32x8 B0 = *(const CAS f32x8*)(cB + (size_t)row * 1024), B1 = *(const CAS f32x8*)(cB + (size_t)row * 1024 + 8);
  f32x8 C0 = *(const CAS f32x8*)(cC + (size_t)row * 1024), C1 = *(const CAS f32x8*)(cC + (size_t)row * 1024 + 8);
  float dt_n = cT[(size_t)row * 32], dA_n = cT[(size_t)row * 32 + 16];
  float x_n = XA[(size_t)row * 1024 + 64 * h + lane];
#pragma unroll 1
  for (int s = 0; s < 2304; ++s) {
    const f32x8 b0 = B0, b1 = B1, c0 = C0, c1 = C1; const float dt = dt_n, dA = dA_n, x = x_n;
    if (s + 1 < 2304) {
      row = scan_row(s + 1, b, dir);
      B0 = *(const CAS f32x8*)(cB + (size_t)row * 1024); B1 = *(const CAS f32x8*)(cB + (size_t)row * 1024 + 8);
      C0 = *(const CAS f32x8*)(cC + (size_t)row * 1024); C1 = *(const CAS f32x8*)(cC + (size_t)row * 1024 + 8);
      dt_n = cT[(size_t)row * 32]; dA_n = cT[(size_t)row * 32 + 16];
      x_n = XA[(size_t)row * 1024 + 64 * h + lane];
    }
    const float dx = dt * x;
    float y = 0.f;
#pragma unroll
    for (int j = 0; j < 8; ++j) { hs[j] = hs[j] * dA + dx * b0[j]; y += hs[j] * c0[j]; }
#pragma unroll
    for (int j = 0; j < 8; ++j) { hs[8 + j] = hs[8 + j] * dA + dx * b1[j]; y += hs[8 + j] * c1[j]; }
    ypart[(s & 15) * 512 + wid * 64 + lane] = y;
    if ((s & 7) == 7) {
      __syncthreads();
      const int fs = s - 7 + wid;
      float o = 0.f;
#pragma unroll
      for (int j = 0; j < 8; ++j) o += ypart[(fs & 15) * 512 + j * 64 + lane];
      const int frow = scan_row(fs, b, dir);
      unsafeAtomicAdd(YB + (size_t)frow * 512 + 64 * h + lane, o);
    }
  }
  __syncthreads();
}

__device__ __forceinline__ int kperm(int i) { return (i & 16) | ((i & 4) << 1) | ((i & 8) >> 1) | (i & 3); }
__device__ __forceinline__ bf16x8 ld16(const bf16_t* p) { return *(const bf16x8*)p; }

template <int NB> struct AttnSt { f32x16 acc[NB]; float m, l; };

template <int NB>
__device__ __forceinline__ void attn_update(AttnSt<NB>& st, f32x16 sv, const bf16_t* vp) {
  float mx = sv[0];
#pragma unroll
  for (int r = 1; r < 16; ++r) mx = fmaxf(mx, sv[r]);
  mx = fmaxf(mx, __shfl_xor(mx, 32));
  const float mn = fmaxf(fmaxf(st.m, mx), -1e30f);
  const float alpha = exp2f(st.m - mn);
  st.m = mn;
  float ps = 0.f; float pv[16];
#pragma unroll
  for (int r = 0; r < 16; ++r) { pv[r] = exp2f(sv[r] - mn); ps += pv[r]; }
  st.l = st.l * alpha + ps;
  u32x4 p0, p1;
  p0.x = cvt_pk_bf16(pv[0], pv[1]); p0.y = cvt_pk_bf16(pv[2], pv[3]); p0.z = cvt_pk_bf16(pv[4], pv[5]); p0.w = cvt_pk_bf16(pv[6], pv[7]);
  p1.x = cvt_pk_bf16(pv[8], pv[9]); p1.y = cvt_pk_bf16(pv[10], pv[11]); p1.z = cvt_pk_bf16(pv[12], pv[13]); p1.w = cvt_pk_bf16(pv[14], pv[15]);
  const bf16x8 pb0 = __builtin_bit_cast(bf16x8, p0), pb1 = __builtin_bit_cast(bf16x8, p1);
#pragma unroll
  for (int nb = 0; nb < NB; ++nb) {
    const bf16x8 va = ld16(vp + (size_t)nb * 32 * 2304), vb = ld16(vp + (size_t)nb * 32 * 2304 + 16);
    f32x16 a = st.acc[nb] * alpha;
    a = __builtin_amdgcn_mfma_f32_32x32x16_bf16(va, pb0, a, 0, 0, 0);
    a = __builtin_amdgcn_mfma_f32_32x32x16_bf16(vb, pb1, a, 0, 0, 0);
    st.acc[nb] = a;
  }
}
__device__ __forceinline__ f32x16 attn_qk(const bf16_t* kp, const bf16x8 (&q)[4]) {
  f32x16 s = {};
#pragma unroll
  for (int kk = 0; kk < 4; ++kk) s = __builtin_amdgcn_mfma_f32_32x32x16_bf16(ld16(kp + 16 * kk), q[kk], s, 0, 0, 0);
  return s;
}

__device__ __forceinline__ void attn_da_item(PRef p, int layer, int item, bool ctxq, LAS unsigned char* lds) {
  const unsigned tid_x = opaque_tid();
  const bf16_t* Z = (const bf16_t*)(p.ws + OFF_BIG + B_Z);
  const bf16_t* Vt = (const bf16_t*)(p.ws + OFF_BIG + B_VTDA);
  bf16_t* BR = (bf16_t*)(p.ws + OFF_BIG + B_BR) + 2ull * T * 512;
  const int wid = tid_x >> 6, lane = tid_x & 63, l31 = lane & 31, hh_ = lane >> 5;
  int b, hh, qb;
  if (!ctxq) { b = item >> 6; hh = (item >> 4) & 3; qb = item & 15; } else { b = item >> 3; hh = (item >> 1) & 3; qb = item & 1; }
  const int m = wid >> 2, qg = wid & 3;
  const int qrow = (ctxq ? TL + b * 256 : b * 2048) + qb * 128 + qg * 32 + l31;
  bf16x8 q[4];
#pragma unroll
  for (int kk = 0; kk < 4; ++kk) q[kk] = ld16(Z + (size_t)qrow * ZLD + Z_DA + hh * 128 + m * 64 + 16 * kk + 8 * hh_);
  AttnSt<4> st;
#pragma unroll
  for (int nb = 0; nb < 4; ++nb) st.acc[nb] = (f32x16){};
  st.m = -1e30f; st.l = 0.f;
  const float sc = 0.125f * 1.4426950408889634f;
  const int kt0 = ctxq ? 64 : 0;
  const bf16_t* vbase = Vt + ((size_t)b * 512 + hh * 128 + l31) * 2304 + 8 * hh_;
#pragma unroll 1
  for (int kt = kt0; kt < 72; ++kt) {
    const int key0 = kt * 32;
    const int krow = (key0 < 2048 ? b * 2048 + key0 : TL + b * 256 + key0 - 2048) + kperm(l31);
    f32x16 s = attn_qk(Z + (size_t)krow * ZLD + Z_DA + 512 + hh * 128 + m * 64 + 8 * hh_, q);
    s = s * sc;
    attn_update<4>(st, s, vbase + key0);
  }
  const float lt = st.l + __shfl_xor(st.l, 32);
  const float inv = 1.0f / lt;
  LAS float* xb = (LAS float*)lds;
  __syncthreads();
  if (m == 1) {
#pragma unroll
    for (int nb = 0; nb < 4; ++nb)
#pragma unroll
      for (int r = 0; r < 16; ++r) xb[(qg * 64 + nb * 16 + r) * 64 + lane] = st.acc[nb][r] * inv;
  }
  __syncthreads();
  if (m == 0) {
    const float* lp = p.da_lambda + (size_t)layer * 256;
    const float d1 = wave_sum(lp[lane] * lp[64 + lane]), d2 = wave_sum(lp[128 + lane] * lp[192 + lane]);
    const float lam_init = 0.8f - 0.6f * expf(-0.3f * (float)layer);
    const float lam = expf(d1) - expf(d2) + lam_init;
    float ss = 0.f;
#pragma unroll
    for (int nb = 0; nb < 4; ++nb)
#pragma unroll
      for (int r = 0; r < 16; ++r) { const float o = st.acc[nb][r] * inv - lam * xb[(qg * 64 + nb * 16 + r) * 64 + lane]; st.acc[nb][r] = o; ss += o * o; }
    ss += __shfl_xor(ss, 32);
    const float rn = rsqrtf(ss * (1.0f / 128.0f) + 1e-5f) * (1.0f - lam_init);
    const float* sg = p.da_subln_g + (size_t)layer * 128;
#pragma unroll
    for (int nb = 0; nb < 4; ++nb)
#pragma unroll
      for (int r4 = 0; r4 < 4; ++r4) {
        const int d0 = nb * 32 + r4 * 8 + 4 * hh_;
        const f32x4 gv = *(const f32x4*)(sg + d0);
        u32x2 w; w.x = cvt_pk_bf16(st.acc[nb][r4 * 4 + 0] * rn * gv[0], st.acc[nb][r4 * 4 + 1] * rn * gv[1]);
        w.y = cvt_pk_bf16(st.acc[nb][r4 * 4 + 2] * rn * gv[2], st.acc[nb][r4 * 4 + 3] * rn * gv[3]);
        *(u32x2*)(BR + (size_t)qrow * 512 + hh * 128 + d0) = w;
      }
  }
}

__device__ __forceinline__ void attn_na_item(PRef p, int layer, int item, bool ctxq, LAS unsigned char* lds) {
  const unsigned tid_x = opaque_tid();
  const bf16_t* Z = (const bf16_t*)(p.ws + OFF_BIG + B_Z);
  const bf16_t* Vt = (const bf16_t*)(p.ws + OFF_BIG + B_VTNA);
  bf16_t* BR = (bf16_t*)(p.ws + OFF_BIG + B_BR) + 3ull * T * 512;
  const int wid = tid_x >> 6, lane = tid_x & 63, l31 = lane & 31, hh_ = lane >> 5;
  int b, h, rg = 0;
  if (!ctxq) { b = item >> 6; h = (item >> 3) & 7; rg = item & 7; } else { b = item >> 3; h = item & 7; }
  LAS float* rpbs = (LAS float*)lds;
  __syncthreads();
  if (tid_x < 465) rpbs[tid_x] = p.na_rpb[((size_t)layer * 8 + h) * 465 + tid_x] * 1.4426950408889634f;
  __syncthreads();
  const int gr = rg * 4 + (wid >> 1), half = wid & 1;
  const int qc = half * 32 + l31;
  const int qrow = ctxq ? TL + b * 256 + wid * 32 + l31 : b * 2048 + gr * 64 + qc;
  bf16x8 q[4];
#pragma unroll
  for (int kk = 0; kk < 4; ++kk) q[kk] = ld16(Z + (size_t)qrow * ZLD + Z_NA + h * 64 + 16 * kk + 8 * hh_);
  AttnSt<2> st;
  st.acc[0] = (f32x16){}; st.acc[1] = (f32x16){}; st.m = -1e30f; st.l = 0.f;
  const float sc = 0.125f * 1.4426950408889634f;
  const bf16_t* vbase = Vt + ((size_t)b * 512 + h * 64 + l31) * 2304 + 8 * hh_;
  const bf16_t* kbase = Z + Z_NA + 512 + h * 64 + 8 * hh_;
  if (!ctxq) {
    const int rstart = min(max(gr - 4, 0), 24);
    const int cstart = min(max(qc - 8, 0), 48);
#pragma unroll 1
    for (int tix = 0; tix < 16; ++tix) {
      const int kr = rstart + (tix >> 1), ch = tix & 1;
      const int key0 = kr * 64 + ch * 32;
      f32x16 s = attn_qk(kbase + (size_t)(b * 2048 + key0 + kperm(l31)) * ZLD, q);
      const int ri = kr - gr + 7;
#pragma unroll
      for (int r = 0; r < 16; ++r) {
        const int kc = ch * 32 + 16 * (r >> 3) + 8 * hh_ + (r & 7);
        const int ci = min(max(kc - qc, -15), 15) + 15;
        const bool in = (kc >= cstart) && (kc < cstart + 16);
        s[r] = in ? s[r] * sc + rpbs[ri * 31 + ci] : -INFINITY;
      }
      attn_update<2>(st, s, vbase + key0);
    }
  }
#pragma unroll 1
  for (int ct = 0; ct < 8; ++ct) {
    f32x16 s = attn_qk(kbase + (size_t)(TL + b * 256 + ct * 32 + kperm(l31)) * ZLD, q);
    s = s * sc;
    attn_update<2>(st, s, vbase + 2048 + ct * 32);
  }
  const float lt = st.l + __shfl_xor(st.l, 32);
  const float inv = 1.0f / lt;
#pragma unroll
  for (int nb = 0; nb < 2; ++nb)
#pragma unroll
    for (int r4 = 0; r4 < 4; ++r4) {
      const int d0 = nb * 32 + r4 * 8 + 4 * hh_;
      u32x2 w; w.x = cvt_pk_bf16(st.acc[nb][r4 * 4 + 0] * inv, st.acc[nb][r4 * 4 + 1] * inv); w.y = cvt_pk_bf16(st.acc[nb][r4 * 4 + 2] * inv, st.acc[nb][r4 * 4 + 3] * inv);
      *(u32x2*)(BR + (size_t)qrow * 512 + h * 64 + d0) = w;
    }
}

__device__ __forceinline__ void phase_mix(PRef p, int layer, bool ctx_out, LAS unsigned char* lds) {
  const unsigned tid_x = opaque_tid();
  if (blockIdx.x < 128) scan_rwkv(p, blockIdx.x, lds);
  else if (blockIdx.x < 256) scan_ssd(p, blockIdx.x - 128, lds);
  unsigned* ctr = (unsigned*)(p.ws + OFF_CTL) + 64 * (1 + layer);
  LAS unsigned* sh = (LAS unsigned*)(lds + 65536 + 4096);
  const int n_items = ctx_out ? 1024 + 128 : 1024;
  for (;;) {
    __syncthreads();
    if (tid_x == 0) *sh = atomicAdd(ctr, 1u);
    __syncthreads();
    const int it = (int)*sh;
    if (it >= n_items) break;
    const bool cq = it >= 1024;
    const bool is_da = cq ? (it < 1088) : (it < 512);
    const int sub = cq ? (it < 1088 ? it - 1024 : it - 1088) : (it < 512 ? it : it - 512);
    if (is_da) attn_da_item(p, layer, sub, cq, lds); else attn_na_item(p, layer, sub, cq, lds);
  }
}

__device__ __forceinline__ void phase_readout(PRef p, int layer, int nrows) {
  const unsigned tid_x = opaque_tid();
  const int wid = tid_x >> 6, lane = tid_x & 63;
  const float* RWS = (const float*)(p.ws + OFF_BIG + B_RWS); const float* RWD = (const float*)(p.ws + OFF_BIG + B_RWD);
  const float* OB = (const float*)(p.ws + OFF_OBUF); const float* YB = (const float*)(p.ws + OFF_YBUF);
  const float* XA = (const float*)(p.ws + OFF_BIG + B_XACT);
  const bf16_t* GB = (const bf16_t*)(p.ws + OFF_BIG + B_GBUF); const bf16_t* Z = (const bf16_t*)(p.ws + OFF_BIG + B_Z);
  bf16_t* BR = (bf16_t*)(p.ws + OFF_BIG + B_BR);
  for (int u = blockIdx.x * 8 + wid; u < nrows * 8; u += gridDim.x * 8) {
    const int row = u >> 3, h = u & 7, c = h * 64 + lane;
    const float o = OB[(size_t)row * 512 + c];
    const float mu = wave_sum(o) * (1.0f / 64.0f);
    const float dv = o - mu;
    const float var = wave_sum(dv * dv) * (1.0f / 64.0f);
    const float on = dv * rsqrtf(var + 64e-5f) * p.rw_ln_g[layer * 512 + c] + p.rw_ln_b[layer * 512 + c];
    const float r = RWS[(size_t)row * 1536 + c], v = RWS[(size_t)row * 1536 + 512 + c];
    const float kf = RWD[(size_t)row * 1536 + 512 + c], kb = RWD[((size_t)T + row) * 1536 + 512 + c];
    const float rk = p.rw_r_k[layer * 512 + c];
    const float sf = wave_sum(r * kf * rk), sb = wave_sum(r * kb * rk);
    const float outv = (on + (sf + sb) * v) * bf2f(GB[(size_t)row * 512 + c]);
    BR[(size_t)row * 512 + c] = (bf16_t)(cvt_pk_bf16(outv, 0.f) & 0xffffu);
  }
  for (int row = blockIdx.x * 8 + wid; row < nrows; row += gridDim.x * 8) {
    const int c0 = lane * 8, h = lane >> 3;
    const float dsk = p.ssd_d[layer * 8 + h];
    const f32x4 y0 = *(const f32x4*)(YB + (size_t)row * 512 + c0), y1 = *(const f32x4*)(YB + (size_t)row * 512 + c0 + 4);
    const f32x4 x0 = *(const f32x4*)(XA + (size_t)row * 1024 + c0), x1 = *(const f32x4*)(XA + (size_t)row * 1024 + c0 + 4);
    const u32x4 zg = *(const u32x4*)(Z + (size_t)row * ZLD + Z_SSD + c0);
    float val[8];
    val[0] = (y0[0] + dsk * x0[0]) * siluf_(bflo(zg.x)); val[1] = (y0[1] + dsk * x0[1]) * siluf_(bfhi(zg.x));
    val[2] = (y0[2] + dsk * x0[2]) * siluf_(bflo(zg.y)); val[3] = (y0[3] + dsk * x0[3]) * siluf_(bfhi(zg.y));
    val[4] = (y1[0] + dsk * x1[0]) * siluf_(bflo(zg.z)); val[5] = (y1[1] + dsk * x1[1]) * siluf_(bfhi(zg.z));
    val[6] = (y1[2] + dsk * x1[2]) * siluf_(bflo(zg.w)); val[7] = (y1[3] + dsk * x1[3]) * siluf_(bfhi(zg.w));
    float ss = 0.f;
#pragma unroll
    for (int j = 0; j < 8; ++j) ss += val[j] * val[j];
    ss = wave_sum(ss);
    const float rs = rsqrtf(ss * (1.0f / 512.0f) + 1e-6f);
    const float* ng = p.ssd_norm_g + layer * 512 + c0;
    u32x4 w; w.x = cvt_pk_bf16(val[0] * rs * ng[0], val[1] * rs * ng[1]); w.y = cvt_pk_bf16(val[2] * rs * ng[2], val[3] * rs * ng[3]);
    w.z = cvt_pk_bf16(val[4] * rs * ng[4], val[5] * rs * ng[5]); w.w = cvt_pk_bf16(val[6] * rs * ng[6], val[7] * rs * ng[7]);
    *(u32x4*)(BR + (size_t)T * 512 + (size_t)row * 512 + c0) = w;
  }
}

__device__ __forceinline__ void phase_act(PRef p, int layer, int nrows) {
  const unsigned tid_x = opaque_tid();
  const bf16_t* U = (const bf16_t*)(p.ws + OFF_BIG + B_U);
  bf16_t* A = (bf16_t*)(p.ws + OFF_BIG + B_ACT);
  const float* cw = p.ffn_conv_w + (size_t)layer * 3 * 11264; const float* cb = p.ffn_conv_b + (size_t)layer * 11264;
  const size_t total = (size_t)nrows * 704;
  for (size_t i = (size_t)blockIdx.x * NTHR + tid_x; i < total; i += (size_t)gridDim.x * NTHR) {
    const int row = (int)(i / 704), j = (int)(i % 704) * 8;
    int s0, s1; seq_bounds(row, s0, s1);
    const bf16_t* uc = U + (size_t)row * 11264 + j;
    const u32x4 z4 = {0u, 0u, 0u, 0u};
    const u32x4 gc = *(const u32x4*)uc, vc = *(const u32x4*)(uc + DFF);
    const u32x4 gp = row > s0 ? *(const u32x4*)(uc - 11264) : z4, vp = row > s0 ? *(const u32x4*)(uc - 11264 + DFF) : z4;
    const u32x4 gn = row + 1 < s1 ? *(const u32x4*)(uc + 11264) : z4, vn = row + 1 < s1 ? *(const u32x4*)(uc + 11264 + DFF) : z4;
    float o[8];
#pragma unroll
    for (int e = 0; e < 8; ++e) {
      const unsigned gpw = gp[e >> 1], gcw = gc[e >> 1], gnw = gn[e >> 1], vpw = vp[e >> 1], vcw = vc[e >> 1], vnw = vn[e >> 1];
      const float a0 = (e & 1) ? bfhi(gpw) : bflo(gpw), a1 = (e & 1) ? bfhi(gcw) : bflo(gcw), a2 = (e & 1) ? bfhi(gnw) : bflo(gnw);
      const float b0 = (e & 1) ? bfhi(vpw) : bflo(vpw), b1 = (e & 1) ? bfhi(vcw) : bflo(vcw), b2 = (e & 1) ? bfhi(vnw) : bflo(vnw);
      const int cg_ = j + e, cv = DFF + j + e;
      const float gt = cb[cg_] + cw[cg_] * a0 + cw[11264 + cg_] * a1 + cw[22528 + cg_] * a2;
      const float vl = cb[cv] + cw[cv] * b0 + cw[11264 + cv] * b1 + cw[22528 + cv] * b2;
      o[e] = siluf_(gt) * vl;
    }
    u32x4 w; w.x = cvt_pk_bf16(o[0], o[1]); w.y = cvt_pk_bf16(o[2], o[3]); w.z = cvt_pk_bf16(o[4], o[5]); w.w = cvt_pk_bf16(o[6], o[7]);
    *(u32x4*)(A + (size_t)row * DFF + j) = w;
  }
}

__device__ __forceinline__ void phase_final(PRef p) {
  const unsigned tid_x = opaque_tid();
  const int wid = tid_x >> 6, lane = tid_x & 63;
  for (int row = blockIdx.x * 8 + wid; row < TL; row += gridDim.x * 8) {
    float* xr = p.out + (size_t)row * 2048;
    f32x4 v[8]; float ss = 0.f;
#pragma unroll
    for (int i = 0; i < 8; ++i) { v[i] = *(const f32x4*)(xr + (i * 64 + lane) * 4); ss += v[i][0] * v[i][0] + v[i][1] * v[i][1] + v[i][2] * v[i][2] + v[i][3] * v[i][3]; }
    ss = wave_sum(ss);
    const float rs = rsqrtf(ss * (1.0f / 2048.0f) + 1e-6f);
#pragma unroll
    for (int i = 0; i < 8; ++i) { const int col = (i * 64 + lane) * 4; *(f32x4*)(xr + col) = v[i] * rs * *(const f32x4*)(p.final_norm_g + col); }
  }
}
__device__ __forceinline__ const CAS Params* launder(const CAS Params* q) { asm volatile("" : "+s"(q)); return q; }
#define P (*launder(kp))
#define WSP(off) (P.ws + (off))
#ifndef MAXPH
#define MAXPH 100
#endif
template <int layer>
__device__ __forceinline__ void layer_body(const CAS Params* kp, LAS unsigned char* lds, cg::grid_group& grid) {
    const bool last = layer == 1;
    const int M = last ? TL : T;
    phase_conv1(P, layer, lds, 0, 3296);
    { PRef p = P; phase_norm(layer == 0 ? p.x : p.out, layer == 0 ? p.ctx : (const float*)(p.ws + OFF_XSC), p.norm1_g + layer * 2048, (const float*)(p.ws + OFF_MOD) + (size_t)layer * 9 * 12288, 0, 1, (bf16_t*)(p.ws + OFF_H), T); }
    grid.sync();
    if (layer * 12 + 1 >= MAXPH) return;
    { PRef p = P; unsigned char* big = p.ws + OFF_BIG; const float* ropeC = (const float*)(p.ws + OFF_ROPE);
      pg8::Gemm g{(const bf16_t*)(p.ws + OFF_H), (const bf16_t*)(p.ws + OFF_WT + WT_WIN), T, ZLD, 2048}; pg8::Sched S; S.init(T, ZLD, gridDim.x, blockIdx.x);
      EpiZ E{(bf16_t*)(big + B_Z), ropeC, ropeC + 1024};
      pg8::gemm_phase<EpiZ, pg8::Sched>(lds, g, S, E); }
    grid.sync();
    if (layer * 12 + 2 >= MAXPH) return;
    phase_prep(P, layer, lds);
    grid.sync();
    if (layer * 12 + 3 >= MAXPH) return;
    phase_mix(P, layer, !last, lds);
    grid.sync();
    if (layer * 12 + 4 >= MAXPH) return;
    phase_readout(P, layer, M);
    grid.sync();
    phase_conv1(P, layer, lds, 3296, 9440);
    grid.sync();
    if (layer * 12 + 5 >= MAXPH) return;
    { PRef p = P; unsigned char* big = p.ws + OFF_BIG;
      pg8::Gemm g{(const bf16_t*)(p.ws + OFF_H), (const bf16_t*)(p.ws + OFF_WT + WT_WG), M, 8192, 2048}; pg8::Sched S; S.init(M, 8192, gridDim.x, blockIdx.x);
      EpiBf16<1> E{(bf16_t*)(big + B_GATES), 8192, p.gate_b + (size_t)layer * 8192};
      pg8::gemm_phase<EpiBf16<1>, pg8::Sched>(lds, g, S, E); }
    grid.sync();
    if (layer * 12 + 6 >= MAXPH) return;
    { PRef p = P; unsigned char* big = p.ws + OFF_BIG;
      pg8::Gemm g{(const bf16_t*)(big + B_BR), (const bf16_t*)(p.ws + OFF_WT + WT_WBR), M, 2048, 512}; pg8::Sched S; S.init(M, 2048, gridDim.x, blockIdx.x, 4, 72, 8);
      EpiMerge E{(const bf16_t*)(big + B_GATES), (float*)(big + B_M32), (bf16_t*)(big + B_M16)};
      pg8::gemm_phase<EpiMerge, pg8::Sched>(lds, g, S, E); }
    grid.sync();
    if (layer * 12 + 7 >= MAXPH) return;
    { PRef p = P; unsigned char* big = p.ws + OFF_BIG; float* XSC = (float*)(p.ws + OFF_XSC);
      pg8::Gemm g{(const bf16_t*)(big + B_M16), (const bf16_t*)(p.ws + OFF_WT + WT_WOUT), M, 2048, 2048}; pg8::Sched S; S.init(M, 2048, gridDim.x, blockIdx.x);
      EpiRes E{layer == 0 ? p.x : p.out, layer == 0 ? p.ctx : XSC, p.out, XSC, (const float*)(p.ws + OFF_MOD) + (size_t)layer * 9 * 12288 + 2 * 2048};
      pg8::gemm_phase<EpiRes, pg8::Sched>(lds, g, S, E); }
    grid.sync();
    if (layer * 12 + 8 >= MAXPH) return;
    phase_conv2(P, layer, lds);
    { PRef p = P; phase_norm(p.out, (const float*)(p.ws + OFF_XSC), p.norm2_g + layer * 2048, (const float*)(p.ws + OFF_MOD) + (size_t)layer * 9 * 12288, 3, 4, (bf16_t*)(p.ws + OFF_H), M); }
    grid.sync();
    if (layer * 12 + 9 >= MAXPH) return;
    { PRef p = P; unsigned char* big = p.ws + OFF_BIG;
      pg8::Gemm g{(const bf16_t*)(p.ws + OFF_H), (const bf16_t*)(p.ws + OFF_WT + WT_WUP), M, 11264, 2048}; pg8::Sched S; S.init(M, 11264, gridDim.x, blockIdx.x);
      EpiBf16<0> E{(bf16_t*)(big + B_U), 11264, nullptr};
      pg8::gemm_phase<EpiBf16<0>, pg8::Sched>(lds, g, S, E); }
    grid.sync();
    if (layer * 12 + 10 >= MAXPH) return;
    phase_act(P, layer, M);
    grid.sync();
    if (layer * 12 + 11 >= MAXPH) return;
    { PRef p = P; unsigned char* big = p.ws + OFF_BIG; float* XSC = (float*)(p.ws + OFF_XSC);
      pg8::Gemm g{(const bf16_t*)(big + B_ACT), (const bf16_t*)(p.ws + OFF_WT + WT_WDN), M, 2048, DFF}; pg8::Sched S; S.init(M, 2048, gridDim.x, blockIdx.x);
      EpiRes E{p.out, XSC, p.out, XSC, (const float*)(p.ws + OFF_MOD) + (size_t)layer * 9 * 12288 + 5 * 2048};
      pg8::gemm_phase<EpiRes, pg8::Sched>(lds, g, S, E); }
    grid.sync();
    if (layer * 12 + 12 >= MAXPH) return;
  }

__global__ void __launch_bounds__(NTHR, 2) fwd_megakernel(Params p_unused) {
  extern __shared__ __attribute__((aligned(16))) unsigned char lds_raw[];
  LAS unsigned char* lds = (LAS unsigned char*)lds_raw;
  cg::grid_group grid = cg::this_grid();
  const CAS Params* kp = (const CAS Params*)__builtin_amdgcn_kernarg_segment_ptr();

  phase_mod(P, lds);
  grid.sync();
  if (0 >= MAXPH) return;
  layer_body<0>(kp, lds, grid);
  if (12 >= MAXPH) return;
  layer_body<1>(kp, lds, grid);
  if (24 >= MAXPH) return;
  phase_final(P);
}

extern "C" void kernel_launch(void* const* d_in, const int* in_sizes, int n_in, void* d_out, int out_size,
                              void* d_ws, size_t ws_size, hipStream_t stream) {
  static int grid_blocks = 0;
  if (!grid_blocks) {
    int dev = 0, cus = 0, per_cu = 0;
    (void)hipGetDevice(&dev);
    (void)hipDeviceGetAttribute(&cus, hipDeviceAttributeMultiprocessorCount, dev);
    (void)hipFuncSetAttribute((const void*)fwd_megakernel, hipFuncAttributeMaxDynamicSharedMemorySize, LDS_BYTES);
    (void)hipOccupancyMaxActiveBlocksPerMultiprocessor(&per_cu, (const void*)fwd_megakernel, NTHR, LDS_BYTES);
    if (per_cu < 1) per_cu = 1;
    grid_blocks = cus * per_cu;
    if (grid_blocks > 256) grid_blocks = 256;
    fprintf(stderr, "grid %d (cus %d per_cu %d) ws %zu need %zu n_in %d\n", grid_blocks, cus, per_cu, ws_size, (size_t)WS_END, n_in);
  }
  if (n_in != 38 || ws_size < WS_END) { fprintf(stderr, "kernel_launch: bad n_in %d or workspace %zu < %zu\n", n_in, ws_size, (size_t)WS_END); return; }
  (void)hipMemsetAsync((char*)d_ws + OFF_CTL, 0, OFF_MOD + MOD_BYTES, stream);
  Params p{};
  const float** pp = (const float**)&p;
  for (int i = 0; i < 38; ++i) pp[i] = (const float*)d_in[i];
  p.out = (float*)d_out; p.ws = (unsigned char*)d_ws;
  void* args[] = {&p};
  hipError_t e = hipLaunchCooperativeKernel((void*)fwd_megakernel, dim3(grid_blocks), dim3(NTHR), args, LDS_BYTES, stream);
  if (e != hipSuccess) fprintf(stderr, "cooperative launch failed: %s (grid %d)\n", hipGetErrorString(e), grid_blocks);
}
```
